# Optimizing an MI355X kernel written in HIP

```python
import jax, jax.numpy as jnp
from jax import lax
import numpy as np

D_MODEL = 2048
BATCH = 1
SEQ = 8192
DEPTH = 1
DEC_BATCH = 16
DEC_SEQ = 16
PAST_LEN = 2048

CHUNK = 64
N_PAST_CHUNKS = 8
BAND_CHUNKS = N_PAST_CHUNKS + 1
BAND_PAST = N_PAST_CHUNKS * CHUNK
ATTN_WIDTH = D_MODEL // 2
HEAD_DIM_A = 64
N_HEADS_A = ATTN_WIDTH // HEAD_DIM_A
REL_CLIP = 128
N_REL = 2 * REL_CLIP + 1
RWKV_WIDTH = D_MODEL - ATTN_WIDTH
HEAD_DIM_B = 64
N_HEADS_B = RWKV_WIDTH // HEAD_DIM_B
DECAY_RANK = 64
AAA_RANK = 64
GATE_RANK = 128
SHIFT_W = 3 * RWKV_WIDTH + DECAY_RANK + AAA_RANK + GATE_RANK
IN_W = 3 * ATTN_WIDTH + SHIFT_W
D_FF = -(-8 * D_MODEL // (3 * 256)) * 256
RMS_EPS = 1e-6
GN_EPS = 64e-5

kernel_name = 'hybrid_chunk_attn_rwkv7_stream_step'

F32 = jnp.float32


def rms_norm(x, g):
    xf = x.astype(F32)
    y = xf * lax.rsqrt(jnp.mean(xf * xf, axis=-1, keepdims=True) + RMS_EPS)
    return (y * g.astype(F32)).astype(x.dtype)


def rel_bias(table, dist):
    return table[:, jnp.clip(dist, -REL_CLIP, REL_CLIP) + REL_CLIP].astype(F32)


def band_attention_prompt(q, k, v, rel_table):
    B, T, H, D = q.shape
    nc = T // CHUNK
    qc = q.reshape(B, nc, CHUNK, H, D)
    pad = ((0, 0), (N_PAST_CHUNKS, 0), (0, 0), (0, 0), (0, 0))
    kp = jnp.pad(k.reshape(B, nc, CHUNK, H, D), pad)
    vp = jnp.pad(v.reshape(B, nc, CHUNK, H, D), pad)
    band_idx = jnp.arange(nc)[:, None] + jnp.arange(BAND_CHUNKS)[None, :]
    kb = kp[:, band_idx].reshape(B, nc, BAND_CHUNKS * CHUNK, H, D)
    vb = vp[:, band_idx].reshape(B, nc, BAND_CHUNKS * CHUNK, H, D)
    dist = BAND_PAST + jnp.arange(CHUNK)[:, None] - jnp.arange(BAND_CHUNKS * CHUNK)[None, :]
    bias = rel_bias(rel_table, dist)
    valid = jnp.repeat(band_idx >= N_PAST_CHUNKS, CHUNK, axis=1)
    s = jnp.einsum('bnqhd,bnkhd->bnhqk', qc, kb).astype(F32) * (HEAD_DIM_A ** -0.5) + bias[None, None]
    s = jnp.where(valid[None, :, None, None, :], s, -jnp.inf)
    p = jax.nn.softmax(s, axis=-1).astype(v.dtype)
    o = jnp.einsum('bnhqk,bnkhd->bnqhd', p, vb)
    return o.reshape(B, T, H, D)


def band_attention_cached(q, k, v, k_cache, v_cache, rel_table):
    P = k_cache.shape[1]
    S = q.shape[1]
    kk = jnp.concatenate([k_cache.astype(k.dtype), k], axis=1)
    vv = jnp.concatenate([v_cache.astype(v.dtype), v], axis=1)
    q_rel = jnp.arange(S) + P
    k_rel = jnp.arange(P + S)
    bias = rel_bias(rel_table, q_rel[:, None] - k_rel[None, :])
    s = jnp.einsum('bqhd,bkhd->bhqk', q, kk).astype(F32) * (HEAD_DIM_A ** -0.5) + bias[None]
    p = jax.nn.softmax(s, axis=-1).astype(v.dtype)
    return jnp.einsum('bhqk,bkhd->bqhd', p, vv)


def rwkv7_time_mix(z, shift0, wkv0, mu, w0, w_w2, a0, a_w2, g_w2, k_k, k_a, r_k, lnx_w, lnx_b):
    B, T, _ = z.shape
    H, N = N_HEADS_B, HEAD_DIM_B
    z_prev = jnp.concatenate([shift0.astype(z.dtype), z[:, :-1]], axis=1)
    zs = (z + (z_prev - z) * mu).astype(F32)
    cuts = [RWKV_WIDTH, 2 * RWKV_WIDTH, 3 * RWKV_WIDTH, 3 * RWKV_WIDTH + DECAY_RANK,
            3 * RWKV_WIDTH + DECAY_RANK + AAA_RANK]
    r, k, v, zw, za, zg = jnp.split(zs, cuts, axis=-1)
    wlog = -jax.nn.softplus(-(w0.astype(F32) + jnp.tanh(zw) @ w_w2.astype(F32))) - 0.5
    decay = jnp.exp(-jnp.exp(wlog))
    a = jax.nn.sigmoid(a0.astype(F32) + za @ a_w2.astype(F32))
    g = jax.nn.sigmoid(zg) @ g_w2.astype(F32)
    kk = (k * k_k.astype(F32)).reshape(B, T, H, N)
    kk = kk / jnp.maximum(jnp.linalg.norm(kk, axis=-1, keepdims=True), 1e-12)
    k = k * (1.0 + (a - 1.0) * k_a.astype(F32))

    def heads_tm(t):
        return jnp.moveaxis(t.reshape(B, T, H, N), 1, 0)

    xs = (heads_tm(r), heads_tm(decay), heads_tm(k), heads_tm(v), jnp.moveaxis(kk, 1, 0), heads_tm(a))

    def step(S, inp):
        r_t, w_t, k_t, v_t, kk_t, a_t = inp
        sa = jnp.einsum('bhvk,bhk->bhv', S, -kk_t)
        S = (S * w_t[:, :, None, :] + sa[..., None] * (kk_t * a_t)[:, :, None, :]
             + v_t[..., None] * k_t[:, :, None, :])
        return S, jnp.einsum('bhvk,bhk->bhv', S, r_t)

    S_T, ys = lax.scan(step, wkv0.astype(F32), xs)
    y = jnp.moveaxis(ys, 0, 1)
    mean = jnp.mean(y, axis=-1, keepdims=True)
    var = jnp.mean(jnp.square(y - mean), axis=-1, keepdims=True)
    yn = ((y - mean) * lax.rsqrt(var + GN_EPS)).reshape(B, T, RWKV_WIDTH) * lnx_w.astype(F32) + lnx_b.astype(F32)
    bonus = (jnp.sum((r * k * r_k.astype(F32)).reshape(B, T, H, N), axis=-1, keepdims=True)
             * v.reshape(B, T, H, N)).reshape(B, T, RWKV_WIDTH)
    out = ((yn + bonus) * g).astype(z.dtype)
    return out, S_T.astype(wkv0.dtype), z[:, -1:]


def trunk_layer(x, attn_fn, shift0, wkv0, lp):
    B, T, _ = x.shape
    n = rms_norm(x, lp['ln1'])
    z = n @ lp['w_in']
    q, k, v = jnp.split(z[..., :3 * ATTN_WIDTH], 3, axis=-1)
    q = q.reshape(B, T, N_HEADS_A, HEAD_DIM_A)
    k = k.reshape(B, T, N_HEADS_A, HEAD_DIM_A)
    v = v.reshape(B, T, N_HEADS_A, HEAD_DIM_A)
    attn_out = attn_fn(q, k, v).reshape(B, T, ATTN_WIDTH)
    rwkv_out, wkv_new, shift_new = rwkv7_time_mix(
        z[..., 3 * ATTN_WIDTH:], shift0, wkv0, lp['mu'], lp['w0'], lp['w_w2'], lp['a0'], lp['a_w2'],
        lp['g_w2'], lp['k_k'], lp['k_a'], lp['r_k'], lp['lnx_w'], lp['lnx_b'])
    h = x + jnp.concatenate([attn_out, rwkv_out.astype(attn_out.dtype)], axis=-1) @ lp['w_o']
    n2 = rms_norm(h, lp['ln2'])
    y = h + (jax.nn.silu(n2 @ lp['w_gate']) * (n2 @ lp['w_up'])) @ lp['w_down']
    return y, k, v, wkv_new, shift_new


def setup_inputs(seed: int = 0) -> dict:
    key = jax.random.key(seed)
    ks = jax.random.split(key, 32)
    kv_rows = min(BAND_PAST, PAST_LEN)
    nrm = jax.random.normal
    w0_base = jnp.linspace(-6.5, -1.0, RWKV_WIDTH, dtype=F32)
    return {
        'x_prompt': nrm(ks[0], (BATCH, SEQ, D_MODEL), F32),
        'x_sample': nrm(ks[1], (DEC_BATCH, DEC_SEQ, D_MODEL), F32),
        'cache_attn_k': nrm(ks[2], (DEPTH, DEC_BATCH, kv_rows, N_HEADS_A, HEAD_DIM_A), F32),
        'cache_attn_v': nrm(ks[3], (DEPTH, DEC_BATCH, kv_rows, N_HEADS_A, HEAD_DIM_A), F32),
        'state_rwkv_wkv': 0.1 * nrm(ks[4], (DEPTH, DEC_BATCH, N_HEADS_B, HEAD_DIM_B, HEAD_DIM_B), F32),
        'state_rwkv_shift': nrm(ks[5], (DEPTH, DEC_BATCH, 1, SHIFT_W), F32),
        'ln1': 1.0 + 0.01 * nrm(ks[6], (DEPTH, D_MODEL), F32),
        'w_in': nrm(ks[7], (DEPTH, D_MODEL, IN_W), F32) * D_MODEL ** -0.5,
        'rel_table': 0.2 * nrm(ks[8], (DEPTH, N_HEADS_A, N_REL), F32),
        'mu': jax.random.uniform(ks[9], (DEPTH, SHIFT_W), F32),
        'w0': w0_base[None] + 0.1 * nrm(ks[10], (DEPTH, RWKV_WIDTH), F32),
        'w_w2': 0.1 * nrm(ks[11], (DEPTH, DECAY_RANK, RWKV_WIDTH), F32) * DECAY_RANK ** -0.5,
        'a0': 0.1 * nrm(ks[12], (DEPTH, RWKV_WIDTH), F32),
        'a_w2': nrm(ks[13], (DEPTH, AAA_RANK, RWKV_WIDTH), F32) * AAA_RANK ** -0.5,
        'g_w2': nrm(ks[14], (DEPTH, GATE_RANK, RWKV_WIDTH), F32) * GATE_RANK ** -0.5,
        'k_k': 0.85 + 0.05 * nrm(ks[15], (DEPTH, RWKV_WIDTH), F32),
        'k_a': 1.0 + 0.05 * nrm(ks[16], (DEPTH, RWKV_WIDTH), F32),
        'r_k': 0.1 * nrm(ks[17], (DEPTH, RWKV_WIDTH), F32),
        'lnx_w': 1.0 + 0.01 * nrm(ks[18], (DEPTH, RWKV_WIDTH), F32),
        'lnx_b': 0.01 * nrm(ks[19], (DEPTH, RWKV_WIDTH), F32),
        'w_o': nrm(ks[20], (DEPTH, D_MODEL, D_MODEL), F32) * D_MODEL ** -0.5,
        'ln2': 1.0 + 0.01 * nrm(ks[21], (DEPTH, D_MODEL), F32),
        'w_gate': nrm(ks[22], (DEPTH, D_MODEL, D_FF), F32) * D_MODEL ** -0.5,
        'w_up': nrm(ks[23], (DEPTH, D_MODEL, D_FF), F32) * D_MODEL ** -0.5,
        'w_down': nrm(ks[24], (DEPTH, D_FF, D_MODEL), F32) * D_FF ** -0.5,
        'final_norm': 1.0 + 0.01 * nrm(ks[25], (D_MODEL,), F32),
    }


def reference(x_prompt, x_sample, cache_attn_k, cache_attn_v, state_rwkv_wkv, state_rwkv_shift,
              ln1, w_in, rel_table, mu, w0, w_w2, a0, a_w2, g_w2, k_k, k_a, r_k, lnx_w, lnx_b,
              w_o, ln2, w_gate, w_up, w_down, final_norm):
    B, T, _ = x_prompt.shape
    n_keep = min(BAND_PAST, T)
    hp, hs = x_prompt, x_sample
    kp_l, vp_l, wp_l, sp_l, ks_l, vs_l, ws_l, ss_l = [], [], [], [], [], [], [], []
    for l in range(DEPTH):
        lp = dict(ln1=ln1[l], w_in=w_in[l], mu=mu[l], w0=w0[l], w_w2=w_w2[l], a0=a0[l], a_w2=a_w2[l],
                  g_w2=g_w2[l], k_k=k_k[l], k_a=k_a[l], r_k=r_k[l], lnx_w=lnx_w[l], lnx_b=lnx_b[l],
                  w_o=w_o[l], ln2=ln2[l], w_gate=w_gate[l], w_up=w_up[l], w_down=w_down[l])
        table = rel_table[l]
        hp, k_p, v_p, wkv_p, sh_p = trunk_layer(
            hp, lambda q, k, v: band_attention_prompt(q, k, v, table),
            jnp.zeros((B, 1, SHIFT_W), hp.dtype), jnp.zeros((B, N_HEADS_B, HEAD_DIM_B, HEAD_DIM_B), F32), lp)
        kp_l.append(k_p[:, -n_keep:]); vp_l.append(v_p[:, -n_keep:]); wp_l.append(wkv_p); sp_l.append(sh_p)
        ck, cv = cache_attn_k[l], cache_attn_v[l]
        hs, k_s, v_s, wkv_s, sh_s = trunk_layer(
            hs, lambda q, k, v: band_attention_cached(q, k, v, ck, cv, table),
            state_rwkv_shift[l], state_rwkv_wkv[l], lp)
        ks_l.append(k_s); vs_l.append(v_s); ws_l.append(wkv_s); ss_l.append(sh_s)
    y_prompt = rms_norm(hp, final_norm)
    y_sample = rms_norm(hs, final_norm)
    return (y_prompt, y_sample,
            jnp.stack(kp_l), jnp.stack(vp_l), jnp.stack(wp_l), jnp.stack(sp_l),
            jnp.stack(ks_l), jnp.stack(vs_l), jnp.stack(ws_l), jnp.stack(ss_l))
```

```cpp
#include <hip/hip_runtime.h>
#include <cstdio>
#include <cstdint>
namespace pg8 {
#define PG8_LAS __attribute__((address_space(3)))
typedef unsigned short bf16_t;
typedef short bf16x8 __attribute__((ext_vector_type(8)));
typedef float f32x4 __attribute__((ext_vector_type(4)));
typedef unsigned u32x4 __attribute__((ext_vector_type(4)));
constexpr int BM = 256, BK = 64, HALF = 128, HTB = HALF * BK * 2, STAGE_BYTES = 8 * HTB, NXCD = 8, WGM = 8;

__host__ __device__ __forceinline__ int lds_byte(int r, int c) { const int st = (r >> 4) * 2 + (c >> 5), rr = r & 15, cc = c & 31, ob = rr * 64 + cc * 2; return st * 1024 + (ob ^ (((ob >> 9) & 1) << 5)); }
__host__ __device__ __forceinline__ void stage_rc(int b, int& R, int& C) { const int st = b / 1024, sb = b % 1024, swz = sb ^ (((sb >> 9) & 1) << 5); R = (st >> 1) * 16 + swz / 64; C = (st & 1) * 32 + (swz % 64) / 2; }
__host__ __device__ __forceinline__ int perm32(int rho) { const int n = rho >> 4, i = rho & 15; return 8 * (i >> 2) + 4 * n + (i & 3); }

struct Unit { int pm, pn; };
struct Gemm { const bf16_t* A; const bf16_t* Bt; int M, N, K; };

struct StaticOrder {
    int nM, nN, nwg, G, c;
    __host__ __device__ void init(int M, int N, int G_, int c_) { nM = M / BM; nN = N / BM; nwg = nM * nN; G = G_; c = c_; }
    __host__ __device__ bool next(int i, Unit& u) const {
        const long L = (long)i * G + c; if (L >= nwg) return false;
        int wgid = (int)L; { const int q = nwg / NXCD, r = nwg % NXCD, xcd = wgid % NXCD, off = wgid / NXCD; wgid = (xcd < r ? xcd * (q + 1) : r * (q + 1) + (xcd - r) * q) + off; }
        const int nig = WGM * nN, gid = wgid / nig, fm = gid * WGM, gsz = (nM - fm) < WGM ? (nM - fm) : WGM;
        u.pm = fm + ((wgid % nig) % gsz); u.pn = (wgid % nig) / gsz; return true;
    }
};

template <class Epi, class Sched, bool ALIGN_EPI = false, bool SP2 = false>
__device__ __forceinline__ void gemm_phase(PG8_LAS unsigned char* lds, const Gemm g, const Sched& S, const Epi& E) {
    const int tid = threadIdx.x, wid = __builtin_amdgcn_readfirstlane(tid >> 6), lane = tid & 63, wr = wid >> 2, wc = wid & 3, fr = lane & 15, fq = lane >> 4;
    const int K = g.K, nt = K / BK;
    unsigned voffA[2], voffB[2];
#pragma unroll
    for (int i = 0; i < 2; ++i) { int R, C; stage_rc(tid * 16 + i * 8192, R, C); const int Rb = Epi::PERM ? ((R & ~31) + perm32(R & 31)) : R;
        voffA[i] = (unsigned)(R * K + C) * 2u; voffB[i] = (unsigned)(Rb * K + C) * 2u; }
    const size_t kstep = (size_t)(BK * 2);
    const size_t hstep = (size_t)HALF * K * 2;
    const size_t tstep = 2 * hstep;
    const unsigned ldsw = (unsigned)wid * 1024u;
    const int aoff = lds_byte(wr * 64 + fr, fq * 8), boff = lds_byte(wc * 32 + fr, fq * 8);
#define PG8_SA(b, h) (((b) * 2 + (h)) * HTB)
#define PG8_SB(b, h) ((4 + (b) * 2 + (h)) * HTB)
#define PG8_STAGE(bufoff, gbase, voff) do { _Pragma("unroll") for (int _i = 0; _i < 2; ++_i) \
        __builtin_amdgcn_global_load_lds((const unsigned*)((const char*)(gbase) + (voff)[_i]), (PG8_LAS unsigned*)(lds + (bufoff) + ldsw + _i * 8192), 16, 0, 0); } while (0)
#define PG8_LDA(dst, b, h) do { _Pragma("unroll") for (int m = 0; m < 4; ++m) _Pragma("unroll") for (int k = 0; k < 2; ++k) dst[m][k] = *(const PG8_LAS bf16x8*)(lds + PG8_SA(b, h) + aoff + m * 2048 + k * 1024); } while (0)
#define PG8_LDB(dst, b, h) do { _Pragma("unroll") for (int n = 0; n < 2; ++n) _Pragma("unroll") for (int k = 0; k < 2; ++k) dst[n][k] = *(const PG8_LAS bf16x8*)(lds + PG8_SB(b, h) + boff + n * 2048 + k * 1024); } while (0)
#define PG8_MMA(ai, bj, At, Bt) do { __builtin_amdgcn_s_setprio(1); _Pragma("unroll") for (int m = 0; m < 4; ++m) _Pragma("unroll") for (int n = 0; n < 2; ++n) _Pragma("unroll") for (int k = 0; k < 2; ++k) \
        acc[ai][bj][m][n] = __builtin_amdgcn_mfma_f32_16x16x32_bf16(Bt[n][k], At[m][k], acc[ai][bj][m][n], 0, 0, 0); __builtin_amdgcn_s_setprio(0); } while (0)
#define PG8_WAIT_V(n) asm volatile("s_waitcnt vmcnt(" #n ")" ::: "memory")
#define PG8_WAIT_L(n) asm volatile("s_waitcnt lgkmcnt(" #n ")" ::: "memory")
#define PG8_BAR __builtin_amdgcn_s_barrier()
#define PG8_SCHED __builtin_amdgcn_sched_barrier(0)
    Unit cur, nxt; int ui = 0;
    if (!S.next(0, cur)) return;
    f32x4 acc[2][2][4][2];
#pragma unroll
    for (int a = 0; a < 2; ++a)
#pragma unroll
        for (int b = 0; b < 2; ++b)
#pragma unroll
            for (int m = 0; m < 4; ++m)
#pragma unroll
                for (int n = 0; n < 2; ++n) acc[a][b][m][n] = (f32x4){0.f, 0.f, 0.f, 0.f};
    bf16x8 At[4][2], B0[2][2], B1[2][2];
    const char* cA = (const char*)g.A + (size_t)cur.pm * tstep; const char* cB = (const char*)g.Bt + (size_t)cur.pn * tstep;
    if constexpr (SP2) {
        PG8_STAGE(PG8_SB(0, 0), cB, voffB); PG8_STAGE(PG8_SB(0, 1), cB + hstep, voffB); PG8_STAGE(PG8_SA(0, 0), cA, voffA); PG8_STAGE(PG8_SA(0, 1), cA + hstep, voffA);
        if (wr == 1) PG8_BAR;
        PG8_WAIT_V(2); PG8_BAR;
        PG8_STAGE(PG8_SB(1, 0), cB + kstep, voffB); PG8_STAGE(PG8_SA(1, 0), cA + kstep, voffA); PG8_STAGE(PG8_SB(1, 1), cB + hstep + kstep, voffB);
        PG8_WAIT_V(6); PG8_BAR;
    } else {
        PG8_STAGE(PG8_SB(0, 0), cB, voffB); PG8_STAGE(PG8_SA(0, 0), cA, voffA); PG8_STAGE(PG8_SB(0, 1), cB + hstep, voffB); PG8_STAGE(PG8_SA(0, 1), cA + hstep, voffA);
        if (wr == 1) PG8_BAR;
        PG8_WAIT_V(4); PG8_BAR;
        PG8_STAGE(PG8_SB(1, 0), cB + kstep, voffB); PG8_STAGE(PG8_SA(1, 0), cA + kstep, voffA); PG8_STAGE(PG8_SB(1, 1), cB + hstep + kstep, voffB);
        PG8_WAIT_V(6); PG8_BAR;
    }
    for (;;) {
        const bool has_next = S.next(ui + 1, nxt);
        const char* nA = has_next ? (const char*)g.A + (size_t)nxt.pm * tstep : cA; const char* nB = has_next ? (const char*)g.Bt + (size_t)nxt.pn * tstep : cB;
        for (int t = 0; t < nt; t += 2) {
            const bool last = (t == nt - 2);
            const char* a1 = cA + (size_t)(t + 1) * kstep;
            const char* a2 = last ? nA : cA + (size_t)(t + 2) * kstep; const char* b2 = last ? nB : cB + (size_t)(t + 2) * kstep;
            const char* a3 = a2 + kstep; const char* b3 = b2 + kstep;
            if constexpr (SP2) {
            PG8_LDB(B0, 0, 0); PG8_LDB(B1, 0, 1); PG8_SCHED; PG8_LDA(At, 0, 0); PG8_STAGE(PG8_SA(1, 1), a1 + hstep, voffA);
            PG8_WAIT_V(8); PG8_WAIT_L(0); PG8_BAR; PG8_MMA(0, 0, At, B0); PG8_MMA(0, 1, At, B1); PG8_BAR; PG8_SCHED;
            PG8_LDA(At, 0, 1); PG8_STAGE(PG8_SB(0, 0), b2, voffB); PG8_STAGE(PG8_SB(0, 1), b2 + hstep, voffB); PG8_STAGE(PG8_SA(0, 0), a2, voffA);
            PG8_WAIT_V(8); PG8_WAIT_L(0); PG8_BAR; PG8_MMA(1, 0, At, B0); PG8_MMA(1, 1, At, B1); PG8_BAR; PG8_SCHED;
            PG8_LDB(B0, 1, 0); PG8_LDB(B1, 1, 1); PG8_SCHED; PG8_LDA(At, 1, 0); PG8_STAGE(PG8_SA(0, 1), a2 + hstep, voffA);
            PG8_WAIT_V(8); PG8_WAIT_L(0); PG8_BAR; PG8_MMA(0, 0, At, B0); PG8_MMA(0, 1, At, B1); PG8_BAR; PG8_SCHED;
            PG8_LDA(At, 1, 1); PG8_STAGE(PG8_SB(1, 0), b3, voffB); PG8_STAGE(PG8_SB(1, 1), b3 + hstep, voffB); PG8_STAGE(PG8_SA(1, 0), a3, voffA);
            PG8_WAIT_V(8); PG8_WAIT_L(0); PG8_BAR; PG8_MMA(1, 0, At, B0); PG8_MMA(1, 1, At, B1); PG8_BAR; PG8_SCHED;
            } else {
            PG8_LDB(B0, 0, 0); PG8_SCHED; PG8_LDA(At, 0, 0); PG8_STAGE(PG8_SA(1, 1), a1 + hstep, voffA);
            PG8_WAIT_L(8); PG8_BAR; PG8_WAIT_L(0); PG8_MMA(0, 0, At, B0); PG8_BAR; PG8_SCHED;
            PG8_LDB(B1, 0, 1); PG8_STAGE(PG8_SB(0, 0), b2, voffB);
            PG8_BAR; PG8_WAIT_L(0); PG8_MMA(0, 1, At, B1); PG8_BAR;
            PG8_LDA(At, 0, 1); PG8_STAGE(PG8_SA(0, 0), a2, voffA);
            PG8_BAR; PG8_WAIT_L(0); PG8_MMA(1, 0, At, B0); PG8_BAR; PG8_SCHED;
            PG8_STAGE(PG8_SB(0, 1), b2 + hstep, voffB);
            PG8_WAIT_V(6); PG8_BAR; PG8_MMA(1, 1, At, B1); PG8_BAR;
            PG8_LDB(B0, 1, 0); PG8_SCHED; PG8_LDA(At, 1, 0); PG8_STAGE(PG8_SA(0, 1), a2 + hstep, voffA);
            PG8_WAIT_L(8); PG8_BAR; PG8_WAIT_L(0); PG8_MMA(0, 0, At, B0); PG8_BAR; PG8_SCHED;
            PG8_LDB(B1, 1, 1); PG8_STAGE(PG8_SB(1, 0), b3, voffB);
            PG8_BAR; PG8_WAIT_L(0); PG8_MMA(0, 1, At, B1); PG8_BAR;
            PG8_LDA(At, 1, 1); PG8_STAGE(PG8_SA(1, 0), a3, voffA);
            PG8_BAR; PG8_WAIT_L(0); PG8_MMA(1, 0, At, B0); PG8_BAR; PG8_SCHED;
            PG8_STAGE(PG8_SB(1, 1), b3 + hstep, voffB);
            PG8_WAIT_V(6); PG8_BAR; PG8_MMA(1, 1, At, B1); PG8_BAR;
            }
        }
        if constexpr (ALIGN_EPI) { if (wr == 0) PG8_BAR; }
        E(acc, cur, wr, wc, fr, fq);
        if (!has_next) break;
#pragma unroll
        for (int a = 0; a < 2; ++a)
#pragma unroll
            for (int b = 0; b < 2; ++b)
#pragma unroll
                for (int m = 0; m < 4; ++m)
#pragma unroll
                    for (int n = 0; n < 2; ++n) acc[a][b][m][n] = (f32x4){0.f, 0.f, 0.f, 0.f};
        cur = nxt; cA = nA; cB = nB; ++ui;
        if constexpr (ALIGN_EPI) { if (wr == 1) PG8_BAR; }
    }
    PG8_WAIT_V(0);
    if constexpr (!ALIGN_EPI) { if (wr == 0) PG8_BAR; }
    PG8_BAR;
#undef PG8_SA
#undef PG8_SB
#undef PG8_STAGE
#undef PG8_LDA
#undef PG8_LDB
#undef PG8_MMA
#undef PG8_WAIT_V
#undef PG8_WAIT_L
#undef PG8_BAR
#undef PG8_SCHED
}
}
constexpr int NWAVES = 8, NTHREADS = 512;
constexpr int MP = 8192, MS = 256, MROWS = MP + MS;
constexpr int DM = 2048, INW = 6400, DFF = 5632, AW = 1024, RW = 1024, ZW = 3328, QKVW = 3072;
constexpr int NCH_P = 2048, NCH_S = 256, NCH = NCH_P + NCH_S;
constexpr int KSROWS = 544;
constexpr float RMS_EPS = 1e-6f, GN_EPS = 64e-5f;
constexpr float LOG2E = 1.4426950408889634f;
constexpr float QSCALE = 0.125f * LOG2E;

constexpr size_t OFF_Y = 0, OFF_YS = 16777216, OFF_KP = 17301504, OFF_VP = 17825792, OFF_WKVP = 18350080, OFF_SHP = 18415616,
                 OFF_KS = 18418944, OFF_VS = 18681088, OFF_WKVS = 18943232, OFF_SHS = 19991808, OUT_TOTAL = 20045056;

constexpr size_t al256(size_t x) { return (x + 255) & ~(size_t)255; }
constexpr size_t WS_CTL = 0, CTL_BYTES = 1u << 20;
constexpr size_t WS_W1T = CTL_BYTES;
constexpr size_t WS_W2T = WS_W1T + (size_t)INW * DM * 2;
constexpr size_t WS_LORA = WS_W2T + (size_t)DM * DM * 2;
constexpr size_t WS_A1 = WS_LORA + 524288;
constexpr size_t WS_QKV = WS_A1 + (size_t)MROWS * DM * 2;
constexpr size_t WS_Z = WS_QKV + (size_t)MROWS * QKVW * 2;
constexpr size_t WS_KS = WS_Z + (size_t)MROWS * ZW * 2;
constexpr size_t WS_VST = WS_KS + (size_t)16 * KSROWS * 1024 * 2;
constexpr size_t WS_RW = WS_VST + (size_t)16 * KSROWS * 1024 * 2;
constexpr size_t RW_PM = 0, RW_Y0 = RW_PM + (size_t)NCH * 8192, RW_GG = RW_Y0 + (size_t)NCH * 8192, RW_BN = RW_GG + (size_t)NCH * 8192,
                 RW_S0 = RW_BN + (size_t)NCH * 8192, RW_GC = RW_S0 + (size_t)NCH * 8192, RW_END = RW_GC + (size_t)NCH * 256;
constexpr size_t FF_BYTES = (size_t)MROWS * DFF * 2;
constexpr size_t RW_BYTES = (RW_END > FF_BYTES ? RW_END : FF_BYTES);
constexpr size_t WS_END = al256(WS_RW + RW_BYTES);
constexpr size_t WS_VT = WS_W1T;
constexpr size_t WS_HB = WS_KS;
constexpr size_t WS_W3T = WS_QKV;
constexpr size_t WS_W4T = WS_W3T + (size_t)2 * DFF * DM * 2;
constexpr size_t WS_FF = WS_RW;
static_assert((size_t)16 * KSROWS * 1024 * 2 * 2 >= (size_t)MROWS * DM * 2, "hb fits KS|VST");
static_assert(WS_W4T + (size_t)DM * DFF * 2 <= WS_KS, "W3T|W4T fit QKV|Z");
static_assert((size_t)1024 * 8192 * 2 <= (size_t)INW * DM * 2, "VT fits W1T");
constexpr size_t DO_GM = 0, DO_QP = (size_t)NCH * 16384;
static_assert(DO_QP + (size_t)NCH * 8192 <= (size_t)(OFF_KP) * 4, "GM|QP fit in the y region of d_out");

constexpr int CW_TMO = 0;
constexpr int CW_BAR = 4096;
constexpr int CW_QATT = 8192, CW_QCONV = 8256, CW_QS4 = 8320;
constexpr int CW_SSQ2 = 16384;
constexpr int CW_SSQ3 = 32768;
static_assert((CW_SSQ3 + MROWS) * 4 <= (int)CTL_BYTES, "ctl");

constexpr int RING_BYTES = 155648;
constexpr int LDSCTL_OFF = RING_BYTES, MISC_OFF = LDSCTL_OFF + 320;
constexpr int LDS_BYTES = 163840;

#define GAS __attribute__((address_space(1)))
#define LAS __attribute__((address_space(3)))
typedef unsigned short bf16;
typedef unsigned v4u __attribute__((ext_vector_type(4)));
typedef unsigned v2u __attribute__((ext_vector_type(2)));
typedef float f32x4 __attribute__((ext_vector_type(4)));
typedef float f32x2 __attribute__((ext_vector_type(2)));
typedef float f32x16 __attribute__((ext_vector_type(16)));
typedef short bf16x8 __attribute__((ext_vector_type(8)));
typedef short bf16x4 __attribute__((ext_vector_type(4)));
typedef GAS unsigned gu32;
#define RLX_AGENT __ATOMIC_RELAXED, __HIP_MEMORY_SCOPE_AGENT
#define LDS_WAIT() asm volatile("s_waitcnt lgkmcnt(0)" ::: "memory")
#define VM_WAIT() asm volatile("s_waitcnt vmcnt(0)" ::: "memory")
__device__ __forceinline__ unsigned f2bf(float f) { unsigned u = __builtin_bit_cast(unsigned, f); return (u + 0x7fffu + ((u >> 16) & 1u)) >> 16; }
__device__ __forceinline__ unsigned pk2(float lo, float hi) { return f2bf(lo) | (f2bf(hi) << 16); }
__device__ __forceinline__ float bf2f(unsigned short b) { return __builtin_bit_cast(float, (unsigned)b << 16); }
__device__ __forceinline__ float bflo(unsigned w) { return __builtin_bit_cast(float, w << 16); }
__device__ __forceinline__ float bfhi(unsigned w) { return __builtin_bit_cast(float, w & 0xffff0000u); }
__device__ __forceinline__ float wave_sum(float v) {
#pragma unroll
    for (int o = 1; o < 64; o <<= 1) v += __shfl_xor(v, o);
    return v;
}
__device__ __forceinline__ float fexp2(float x) { return __builtin_amdgcn_exp2f(x); }
__device__ __forceinline__ float fexp(float x) { return __builtin_amdgcn_exp2f(x * LOG2E); }
__device__ __forceinline__ float frcp(float x) { return __builtin_amdgcn_rcpf(x); }
__device__ __forceinline__ float fsigmoid(float x) { return frcp(1.f + fexp(-x)); }
__device__ __forceinline__ f32x16 mfma32(bf16x8 a, bf16x8 b, f32x16 c) { return __builtin_amdgcn_mfma_f32_32x32x16_bf16(a, b, c, 0, 0, 0); }
__device__ __forceinline__ f32x4 mfma16(bf16x8 a, bf16x8 b, f32x4 c) { return __builtin_amdgcn_mfma_f32_16x16x32_bf16(a, b, c, 0, 0, 0); }

#define XB_TMO      128
#define XB_XCNT(j)  (256  + 64 * (j))
#define XB_XSUB(j)  (1280 + 64 * (j))
#define XB_XGEN(j)  (2304 + 64 * (j))
#define XB_TOP      3328
#define XB_TOPGEN   3392
#define XCD_BAR_WORDS 3456
#define XB_SPIN_CAP (1u << 22)
__device__ __forceinline__ unsigned xb_ld(unsigned* p)              { return __hip_atomic_load(p, __ATOMIC_RELAXED, __HIP_MEMORY_SCOPE_AGENT); }
__device__ __forceinline__ unsigned xb_add(unsigned* p, unsigned v) { return __hip_atomic_fetch_add(p, v, __ATOMIC_RELAXED, __HIP_MEMORY_SCOPE_AGENT); }
__device__ __forceinline__ unsigned xb_xcc_id() { return (unsigned)__builtin_amdgcn_s_getreg((3 << 11) | 20) & 0xFu; }
#define XB_SPIN(cond, bar) do { unsigned _sp = 0; while (cond) { __builtin_amdgcn_s_sleep(1); \
    if ((++_sp & 255u) == 0u) { if (xb_ld(&(bar)[XB_TMO])) break; if (_sp > XB_SPIN_CAP) { atomicAdd(&(bar)[XB_TMO], 1u); break; } } } } while (0)
struct XcdBarrier { unsigned* bar; unsigned x; volatile LAS unsigned* st; };
__device__ __forceinline__ XcdBarrier xcd_barrier_post(unsigned* bar, volatile LAS unsigned* st) {
    XcdBarrier b; b.bar = bar; b.x = xb_xcc_id(); b.st = st;
    if (threadIdx.x == 0) (void)xb_add(&bar[XB_XCNT(b.x)], 1u);
    return b;
}
__device__ __forceinline__ void xcd_barrier_complete(unsigned* bar, unsigned x, unsigned& nloc, unsigned& nx) {
    const unsigned G = gridDim.x * gridDim.y * gridDim.z;
    unsigned sum, cnt, mine, sp = 0u;
    for (;;) {
        sum = 0u; cnt = 0u; mine = 0u;
#pragma unroll
        for (unsigned j = 0; j < 16; ++j) { const unsigned c = xb_ld(&bar[XB_XCNT(j)]); sum += c; cnt += (c > 0u) ? 1u : 0u; mine = (j == x) ? c : mine; }
        if (sum == G) break;
        __builtin_amdgcn_s_sleep(1);
        if ((++sp & 255u) == 0u) { if (xb_ld(&bar[XB_TMO])) break; if (sp > XB_SPIN_CAP) { atomicAdd(&bar[XB_TMO], 1u); break; } }
    }
    nloc = mine > 0u ? mine : 1u; nx = cnt > 0u ? cnt : 1u;
}
__device__ __forceinline__ void xcd_barrier(const XcdBarrier& b) {
    asm volatile("s_waitcnt vmcnt(0)" ::: "memory");
    __syncthreads();
    if (threadIdx.x == 0) {
        unsigned* bar = b.bar;
        __builtin_amdgcn_s_waitcnt(0);
        unsigned nloc = b.st[0], nx = b.st[1];
        if (nloc == 0u) { xcd_barrier_complete(bar, b.x, nloc, nx); b.st[0] = nloc; b.st[1] = nx; }
        const unsigned old = xb_add(&bar[XB_XSUB(b.x)], 1u);
        const unsigned gen = old / nloc;
        if (old + 1u == (gen + 1u) * nloc) {
            __builtin_amdgcn_fence(__ATOMIC_RELEASE, "agent");
            asm volatile("s_waitcnt vmcnt(0)" ::: "memory");
            const unsigned og = xb_add(&bar[XB_TOP], 1u);
            const unsigned tg = og / nx;
            if (og + 1u == (tg + 1u) * nx) xb_add(&bar[XB_TOPGEN], 1u);
            else XB_SPIN(xb_ld(&bar[XB_TOPGEN]) == tg, bar);
            __builtin_amdgcn_fence(__ATOMIC_ACQUIRE, "agent");
            xb_add(&bar[XB_XGEN(b.x)], 1u);
            asm volatile("s_waitcnt vmcnt(0)" ::: "memory");
        } else {
            XB_SPIN(xb_ld(&bar[XB_XGEN(b.x)]) == gen, bar);
            __builtin_amdgcn_fence(__ATOMIC_ACQUIRE, "agent");
            asm volatile("s_waitcnt vmcnt(0)" ::: "memory");
        }
    }
    __syncthreads();
}

struct Args {
    const float* in[26];
    float* out; unsigned char* ws;
};
__device__ __forceinline__ v4u pack8(f32x4 a, f32x4 b) { v4u w; w.x = pk2(a[0], a[1]); w.y = pk2(a[2], a[3]); w.z = pk2(b[0], b[1]); w.w = pk2(b[2], b[3]); return w; }

struct EpiG1 {
    static constexpr bool PERM = true;
    bf16* QKV; bf16* Z; float* out;
    __device__ __forceinline__ void operator()(const f32x4 (&acc)[2][2][4][2], const pg8::Unit& u, int wr, int wc, int fr, int fq) const {
        const int pn = u.pn, pm = u.pm;
        const int rowb = pm * 256 + wr * 64 + fr, cb = wc * 32 + 8 * fq;
#pragma unroll
        for (int ai = 0; ai < 2; ++ai)
#pragma unroll
            for (int m = 0; m < 4; ++m) {
                const int row = rowb + ai * 128 + m * 16;
#pragma unroll
                for (int bj = 0; bj < 2; ++bj) {
                    const int c = pn * 256 + bj * 128 + cb;
                    f32x4 v0 = acc[ai][bj][m][0], v1 = acc[ai][bj][m][1];
                    if (pn < 12) {
                        if (pn >= 4) {
                            const bool isk = pn < 8; const int cc = c - (isk ? 1024 : 2048);
                            float* dst = nullptr;
                            if (pm == 30 || pm == 31) dst = out + (isk ? OFF_KP : OFF_VP) + (size_t)(row - 7680) * 1024 + cc;
                            else if (pm == 32) dst = out + (isk ? OFF_KS : OFF_VS) + (size_t)(row - 8192) * 1024 + cc;
                            if (dst) { *(f32x4*)dst = v0; *(f32x4*)(dst + 4) = v1; }
                        } else { v0 = v0 * QSCALE; v1 = v1 * QSCALE; }
                        *(v4u*)(QKV + (size_t)row * QKVW + c) = pack8(v0, v1);
                    } else {
                        const int cz = c - QKVW;
                        *(v4u*)(Z + (size_t)row * ZW + cz) = pack8(v0, v1);
                        float* dst = nullptr;
                        if (row == MP - 1) dst = out + OFF_SHP + cz;
                        else if (pm == 32 && fr == 15) dst = out + OFF_SHS + (size_t)((row - MP) >> 4) * ZW + cz;
                        if (dst) { *(f32x4*)dst = v0; *(f32x4*)(dst + 4) = v1; }
                    }
                }
            }
    }
};

struct EpiG2 {
    static constexpr bool PERM = true;
    const float* xp; const float* xs; float* h; bf16* hb; float* ssq;
    __device__ __forceinline__ void operator()(const f32x4 (&acc)[2][2][4][2], const pg8::Unit& u, int wr, int wc, int fr, int fq) const {
        const int rowb = u.pm * 256 + wr * 64 + fr, cb = u.pn * 256 + wc * 32 + 8 * fq;
#pragma unroll
        for (int ai = 0; ai < 2; ++ai)
#pragma unroll
            for (int m = 0; m < 4; ++m) {
                const int row = rowb + ai * 128 + m * 16;
                const float* xr = row < MP ? xp + (size_t)row * DM : xs + (size_t)(row - MP) * DM;
                float sq = 0.f;
#pragma unroll
                for (int bj = 0; bj < 2; ++bj) {
                    const int c = cb + bj * 128;
                    const f32x4 v0 = acc[ai][bj][m][0] + *(const f32x4*)(xr + c), v1 = acc[ai][bj][m][1] + *(const f32x4*)(xr + c + 4);
                    float* hp = h + (size_t)row * DM + c; *(f32x4*)hp = v0; *(f32x4*)(hp + 4) = v1;
                    *(v4u*)(hb + (size_t)row * DM + c) = pack8(v0, v1);
                    sq += (v0[0] * v0[0] + v0[1] * v0[1]) + (v0[2] * v0[2] + v0[3] * v0[3]) + (v1[0] * v1[0] + v1[1] * v1[1]) + (v1[2] * v1[2] + v1[3] * v1[3]);
                }
                sq += __shfl_xor(sq, 16); sq += __shfl_xor(sq, 32);
                if (fq == 0) atomicAdd(ssq + row, sq);
            }
    }
};

struct EpiG3 {
    static constexpr bool PERM = true;
    const float* ssq; bf16* ff;
    __device__ __forceinline__ void operator()(const f32x4 (&acc)[2][2][4][2], const pg8::Unit& u, int wr, int wc, int fr, int fq) const {
        const int rowb = u.pm * 256 + wr * 64 + fr, cb = u.pn * 128 + wc * 32 + 8 * fq;
#pragma unroll
        for (int ai = 0; ai < 2; ++ai)
#pragma unroll
            for (int m = 0; m < 4; ++m) {
                const int row = rowb + ai * 128 + m * 16;
                const float rs = __builtin_amdgcn_rsqf(ssq[row] * (1.f / DM) + RMS_EPS);
                f32x4 o[2];
#pragma unroll
                for (int n = 0; n < 2; ++n)
#pragma unroll
                    for (int e = 0; e < 4; ++e) { const float g = acc[ai][0][m][n][e] * rs, up = acc[ai][1][m][n][e] * rs; o[n][e] = g * frcp(1.f + fexp(-g)) * up; }
                *(v4u*)(ff + (size_t)row * DFF + cb) = pack8(o[0], o[1]);
            }
    }
};

struct EpiG4 {
    static constexpr bool PERM = true;
    float* h; float* ssq;
    __device__ __forceinline__ void operator()(const f32x4 (&acc)[2][2][4][2], const pg8::Unit& u, int wr, int wc, int fr, int fq) const {
        const int rowb = u.pm * 256 + wr * 64 + fr, cb = u.pn * 256 + wc * 32 + 8 * fq;
#pragma unroll
        for (int ai = 0; ai < 2; ++ai)
#pragma unroll
            for (int m = 0; m < 4; ++m) {
                const int row = rowb + ai * 128 + m * 16;
                float sq = 0.f;
#pragma unroll
                for (int bj = 0; bj < 2; ++bj) {
                    float* hp = h + (size_t)row * DM + cb + bj * 128;
                    const f32x4 v0 = acc[ai][bj][m][0] + *(const f32x4*)hp, v1 = acc[ai][bj][m][1] + *(const f32x4*)(hp + 4);
                    *(f32x4*)hp = v0; *(f32x4*)(hp + 4) = v1;
                    sq += (v0[0] * v0[0] + v0[1] * v0[1]) + (v0[2] * v0[2] + v0[3] * v0[3]) + (v1[0] * v1[0] + v1[1] * v1[1]) + (v1[2] * v1[2] + v1[3] * v1[3]);
                }
                sq += __shfl_xor(sq, 16); sq += __shfl_xor(sq, 32);
                if (fq == 0) atomicAdd(ssq + row, sq);
            }
    }
};
__device__ __forceinline__ void tr_item(const float* W, int ldw, bf16* WT, size_t ldo, int k0, int n0, int orow0, const float* kscale, LAS float* scr, int lane) {
#pragma unroll 8
    for (int i = 0; i < 32; ++i) { const int kk = 2 * i + (lane >> 5); float v = W[(size_t)(k0 + kk) * ldw + n0 + (lane & 31)]; if (kscale) v *= kscale[k0 + kk]; scr[kk * 33 + (lane & 31)] = v; }
    LDS_WAIT(); asm volatile("" ::: "memory");
    const int c = lane & 7;
#pragma unroll
    for (int j = 0; j < 4; ++j) { const int n = (lane >> 3) + 8 * j; const LAS float* s = scr + (8 * c) * 33 + n;
        v4u o; o.x = pk2(s[0 * 33], s[1 * 33]); o.y = pk2(s[2 * 33], s[3 * 33]); o.z = pk2(s[4 * 33], s[5 * 33]); o.w = pk2(s[6 * 33], s[7 * 33]);
        *(v4u*)(WT + (size_t)(orow0 + n) * ldo + k0 + 8 * c) = o; }
    LDS_WAIT(); asm volatile("" ::: "memory");
}
__device__ __forceinline__ void rms_row(const float* xrow, const float* g, bf16* orow, int lane) {
    const f32x4* xr = (const f32x4*)xrow + lane; const f32x4* gr = (const f32x4*)g + lane;
    f32x4 v[8]; float s = 0.f;
#pragma unroll
    for (int j = 0; j < 8; ++j) { v[j] = xr[64 * j]; s += (v[j][0] * v[j][0] + v[j][1] * v[j][1]) + (v[j][2] * v[j][2] + v[j][3] * v[j][3]); }
    const float rstd = __builtin_amdgcn_rsqf(wave_sum(s) * (1.f / DM) + RMS_EPS);
    v2u* o8 = (v2u*)orow + lane;
#pragma unroll
    for (int j = 0; j < 8; ++j) { const f32x4 gg = gr[64 * j]; v2u w; w.x = pk2(v[j][0] * rstd * gg[0], v[j][1] * rstd * gg[1]); w.y = pk2(v[j][2] * rstd * gg[2], v[j][3] * rstd * gg[3]); o8[64 * j] = w; }
}
__device__ __forceinline__ void cvt_row1024(const float* src, bf16* dst, int lane) {
    const f32x4* s = (const f32x4*)src + lane; v2u* o = (v2u*)dst + lane;
#pragma unroll
    for (int j = 0; j < 4; ++j) { const f32x4 v = s[64 * j]; v2u w; w.x = pk2(v[0], v[1]); w.y = pk2(v[2], v[3]); o[64 * j] = w; }
}

struct P0Params { const float *xp, *xs, *ck, *cv, *ln1, *w_in, *w_w2, *a_w2, *g_w2, *w_o; bf16 *W1T, *W2T, *LWT, *LAT, *LGT, *A1, *KS, *VST; };
__device__ __forceinline__ void p0_prologue(const P0Params& P, LAS unsigned char* lds, int gw, int NGW, int wave, int lane) {
    LAS float* scr = (LAS float*)(lds + wave * 16384);
    constexpr int I_W1 = (DM / 64) * (INW / 32), I_W2 = (DM / 64) * (DM / 32), I_LW = 32, I_LA = 32, I_LG = 64, I_CV = 16 * 8 * 32;
    constexpr int NITEMS = I_W1 + I_W2 + I_LW + I_LA + I_LG + I_CV;
    for (int it = gw; it < NITEMS; it += NGW) {
        int r = it;
        if (r < I_W1) { const int nb = INW / 32; tr_item(P.w_in, INW, P.W1T, DM, 64 * (r / nb), 32 * (r % nb), 32 * (r % nb), nullptr, scr, lane); continue; } r -= I_W1;
        if (r < I_W2) { const int nb = DM / 32; tr_item(P.w_o, DM, P.W2T, DM, 64 * (r / nb), 32 * (r % nb), 32 * (r % nb), nullptr, scr, lane); continue; } r -= I_W2;
        if (r < I_LW) { tr_item(P.w_w2, RW, P.LWT, 64, 0, 32 * r, 32 * r, nullptr, scr, lane); continue; } r -= I_LW;
        if (r < I_LA) { tr_item(P.a_w2, RW, P.LAT, 64, 0, 32 * r, 32 * r, nullptr, scr, lane); continue; } r -= I_LA;
        if (r < I_LG) { tr_item(P.g_w2, RW, P.LGT, 128, 64 * (r / 32), 32 * (r % 32), 32 * (r % 32), nullptr, scr, lane); continue; } r -= I_LG;
        { const int b = r / 256, q = r % 256, kb = q / 32, nb = q % 32;
          tr_item(P.cv + (size_t)b * 512 * 1024, 1024, P.VST + (size_t)b * 1024 * KSROWS, KSROWS, 64 * kb, 32 * nb, 32 * nb, nullptr, scr, lane); }
    }
    for (int m = gw; m < MROWS; m += NGW) rms_row(m < MP ? P.xp + (size_t)m * DM : P.xs + (size_t)(m - MP) * DM, P.ln1, P.A1 + (size_t)m * DM, lane);
    for (int m = gw; m < 16 * 512; m += NGW) { const int b = m >> 9, t = m & 511; cvt_row1024(P.ck + (size_t)m * 1024, P.KS + ((size_t)b * KSROWS + t) * 1024, lane); }
}

__device__ __forceinline__ void final_norm_row(float* row, const float* g, float ssq, int lane) {
    const float rs = __builtin_amdgcn_rsqf(ssq * (1.f / DM) + RMS_EPS);
    f32x4* xr = (f32x4*)row + lane; const f32x4* gr = (const f32x4*)g + lane;
#pragma unroll
    for (int j = 0; j < 8; ++j) { f32x4 v = xr[64 * j]; const f32x4 gg = gr[64 * j]; v = v * rs; v = v * gg; xr[64 * j] = v; }
}
constexpr int PB = 144;
constexpr int L_LFW = 0, L_LFA = 9216, L_LFG = 18432;
constexpr int L_LP = 0, L_AAK = 16384;
constexpr int L_ACT = 27648, ACT_PITCH = 528;
constexpr int L_AQB = 27648, L_AQK = 36864, L_RHS2 = 46080;
constexpr int L_AM = 62464, L_RM = 71680, L_BM = 80896, L_KM = 90112;
constexpr int L_XT = 80896;
constexpr int L_BHT = 99328, L_KHT = 108544, L_VTT = 117760;
constexpr int L_CUMT = 126976;
static_assert(L_CUMT + 2048 <= RING_BYTES, "rwkv lds");

#define BLK_SYNC() do { asm volatile("s_waitcnt vmcnt(0) lgkmcnt(0)" ::: "memory"); __builtin_amdgcn_s_barrier(); asm volatile("" ::: "memory"); } while (0)
#define LDS_SYNC() do { asm volatile("s_waitcnt lgkmcnt(0)" ::: "memory"); __builtin_amdgcn_s_barrier(); asm volatile("" ::: "memory"); } while (0)

__device__ __forceinline__ f32x16 mm_tile(LAS const unsigned char* A, LAS const unsigned char* B, int mt, int nt, int lane, f32x16 acc) {
    const int row = lane & 31, h = lane >> 5;
    LAS const unsigned char* pa = A + (32 * mt + row) * PB + h * 16;
    LAS const unsigned char* pb = B + (32 * nt + row) * PB + h * 16;
#pragma unroll
    for (int s = 0; s < 4; ++s) { const bf16x8 a = *(LAS const bf16x8*)(pa + s * 32); const bf16x8 b = *(LAS const bf16x8*)(pb + s * 32); acc = mfma32(a, b, acc); }
    return acc;
}
#define CROW(r, h) (((r) & 3) + 8 * ((r) >> 2) + 4 * (h))

struct RwkvParams {
    const bf16* Z; const float* shift_in; const float *mu, *w0, *a0, *k_k, *k_a, *r_k;
    const bf16 *LWT, *LAT, *LGT;
    bf16 *PM, *Y0, *GG, *BN, *QP; float *GM, *GC;
};

__device__ __forceinline__ void rwkv_chunk(const RwkvParams& P, int ch, LAS unsigned char* lds, int tid, int wave, int lane) {
    const bool samp = ch >= NCH_P; const int hd = ch & 15; const int cb = samp ? (ch - NCH_P) >> 4 : ch >> 4;
    const int row0 = samp ? MP + 16 * cb : 64 * cb; const int nvalid = samp ? 16 : 64;
    const float* shp = samp ? P.shift_in + (size_t)cb * ZW : nullptr;
    const bool prev_zero = (!samp && cb == 0);
    {
        const int col = tid & 255, th = tid >> 8, zc = 3072 + col;
        const float muc = P.mu[zc];
        float prev;
        if (th == 0) prev = prev_zero ? 0.f : (samp ? shp[zc] : bf2f(P.Z[(size_t)(row0 - 1) * ZW + zc]));
        else prev = (31 < nvalid) ? bf2f(P.Z[(size_t)(row0 + 31) * ZW + zc]) : 0.f;
#pragma unroll 4
        for (int i = 0; i < 32; ++i) {
            const int t = 32 * th + i; float a = 0.f;
            if (t < nvalid) {
                const float z = bf2f(P.Z[(size_t)(row0 + t) * ZW + zc]);
                const float zs = z + (prev - z) * muc; prev = z;
                if (col < 64) { const float e = fexp(2.f * zs); a = 1.f - 2.f * frcp(e + 1.f); }
                else if (col < 128) a = zs;
                else a = fsigmoid(zs);
            }
            *(LAS bf16*)(lds + L_ACT + t * ACT_PITCH + col * 2) = (bf16)f2bf(a);
        }
    }
    LDS_SYNC();
    {
        const int w4 = wave & 3, mt = w4 >> 1, nt = w4 & 1, row = lane & 31, h = lane >> 5;
        LAS const unsigned char* pa = lds + L_ACT + (32 * mt + row) * ACT_PITCH + h * 16;
        const int jg = 64 * hd + 32 * nt + row;
        if (wave < 4) {
            f32x16 aw = {}, aa = {};
            const bf16* bw = P.LWT + (size_t)jg * 64 + h * 8; const bf16* ba = P.LAT + (size_t)jg * 64 + h * 8;
#pragma unroll
            for (int s = 0; s < 4; ++s) {
                aw = mfma32(*(LAS const bf16x8*)(pa + s * 32), *(const bf16x8*)(bw + s * 16), aw);
                aa = mfma32(*(LAS const bf16x8*)(pa + 128 + s * 32), *(const bf16x8*)(ba + s * 16), aa);
            }
#pragma unroll
            for (int r = 0; r < 16; ++r) { const int t = 32 * mt + CROW(r, h), j = 32 * nt + row;
                *(LAS bf16*)(lds + L_LFW + t * PB + j * 2) = (bf16)f2bf(aw[r]); *(LAS bf16*)(lds + L_LFA + t * PB + j * 2) = (bf16)f2bf(aa[r]); }
        } else {
            f32x16 ag = {};
            const bf16* bg = P.LGT + (size_t)jg * 128 + h * 8;
#pragma unroll
            for (int s = 0; s < 8; ++s) ag = mfma32(*(LAS const bf16x8*)(pa + 256 + s * 32), *(const bf16x8*)(bg + s * 16), ag);
#pragma unroll
            for (int r = 0; r < 16; ++r) { const int t = 32 * mt + CROW(r, h), j = 32 * nt + row; *(LAS bf16*)(lds + L_LFG + t * PB + j * 2) = (bf16)f2bf(ag[r]); }
        }
    }
    LDS_SYNC();
    {
        const int j = lane, tg = wave, jh = 64 * hd + j, t0 = 8 * tg;
        const float mur = P.mu[jh], muk = P.mu[1024 + jh], muv = P.mu[2048 + jh];
        const float w0v = P.w0[jh], a0v = P.a0[jh], kkw = P.k_k[jh], kaw = P.k_a[jh], rkw = P.r_k[jh];
        float pr = 0.f, pk = 0.f, pv = 0.f;
        if (tg == 0) { if (!prev_zero) { if (samp) { pr = shp[jh]; pk = shp[1024 + jh]; pv = shp[2048 + jh]; }
                                          else { const bf16* zp = P.Z + (size_t)(row0 - 1) * ZW + jh; pr = bf2f(zp[0]); pk = bf2f(zp[1024]); pv = bf2f(zp[2048]); } } }
        else if (t0 - 1 < nvalid) { const bf16* zp = P.Z + (size_t)(row0 + t0 - 1) * ZW + jh; pr = bf2f(zp[0]); pk = bf2f(zp[1024]); pv = bf2f(zp[2048]); }
        float lw2[8], cl[8], rr[8], kp[8], vv[8], kk[8], al[8];
        bf16* ggp = P.GG + (size_t)ch * 4096 + j; bf16* bnp = P.BN + (size_t)ch * 4096 + j;
        float run = 0.f;
#pragma unroll
        for (int i = 0; i < 8; ++i) {
            const int t = t0 + i; const bool valid = t < nvalid;
            float zr = 0.f, zk = 0.f, zv = 0.f;
            if (valid) { const bf16* zp = P.Z + (size_t)(row0 + t) * ZW + jh; zr = bf2f(zp[0]); zk = bf2f(zp[1024]); zv = bf2f(zp[2048]); }
            const float r = zr + (pr - zr) * mur, k = zk + (pk - zk) * muk, v = zv + (pv - zv) * muv; pr = zr; pk = zk; pv = zv;
            const float dW = bf2f(*(LAS const bf16*)(lds + L_LFW + t * PB + j * 2)), dA = bf2f(*(LAS const bf16*)(lds + L_LFA + t * PB + j * 2)), g = bf2f(*(LAS const bf16*)(lds + L_LFG + t * PB + j * 2));
            const float x = -(w0v + dW);
            const float sp = fmaxf(x, 0.f) + __logf(1.f + fexp(-fabsf(x)));
            const float lw = -fexp(-sp - 0.5f);
            const float alpha = fsigmoid(a0v + dA);
            const float kkr = k * kkw; const float n2 = wave_sum(kkr * kkr);
            const float kkn = kkr * frcp(fmaxf(sqrtf(n2), 1e-12f));
            const float kmod = k * (1.f + (alpha - 1.f) * kaw);
            const float bs = wave_sum(r * kmod * rkw);
            lw2[i] = valid ? lw * LOG2E : 0.f; rr[i] = valid ? r : 0.f; kp[i] = valid ? kmod : 0.f; vv[i] = valid ? v : 0.f; kk[i] = valid ? kkn : 0.f; al[i] = alpha;
            run += lw2[i]; cl[i] = run;
            ggp[t * 64] = (bf16)f2bf(g); bnp[t * 64] = (bf16)f2bf(valid ? bs * v : 0.f);
        }
        LAS float* cum = (LAS float*)(lds + L_CUMT);
        cum[tg * 64 + j] = run;
        LDS_SYNC();
        float off = 0.f, tot = 0.f;
#pragma unroll
        for (int g8 = 0; g8 < 8; ++g8) { const float c = cum[g8 * 64 + j]; tot += c; off += (g8 < tg) ? c : 0.f; }
        float bh[8], kh[8];
#pragma unroll
        for (int i = 0; i < 8; ++i) {
            const int t = t0 + i; const float cu = off + cl[i];
            const float gin = fexp2(cu), gex = fexp2(cu - lw2[i]), ginv = fexp2(-cu), gend = fexp2(tot - cu);
            const float b = kk[i] * al[i];
            *(LAS bf16*)(lds + L_AM + t * PB + j * 2) = (bf16)f2bf(-gex * kk[i]);
            *(LAS bf16*)(lds + L_RM + t * PB + j * 2) = (bf16)f2bf(gin * rr[i]);
            *(LAS bf16*)(lds + L_BM + t * PB + j * 2) = (bf16)f2bf(b * ginv);
            *(LAS bf16*)(lds + L_KM + t * PB + j * 2) = (bf16)f2bf(kp[i] * ginv);
            bh[i] = b * gend; kh[i] = kp[i] * gend;
        }
        v4u w;
        w.x = pk2(bh[0], bh[1]); w.y = pk2(bh[2], bh[3]); w.z = pk2(bh[4], bh[5]); w.w = pk2(bh[6], bh[7]); *(LAS v4u*)(lds + L_BHT + j * PB + tg * 16) = w;
        w.x = pk2(kh[0], kh[1]); w.y = pk2(kh[2], kh[3]); w.z = pk2(kh[4], kh[5]); w.w = pk2(kh[6], kh[7]); *(LAS v4u*)(lds + L_KHT + j * PB + tg * 16) = w;
        w.x = pk2(vv[0], vv[1]); w.y = pk2(vv[2], vv[3]); w.z = pk2(vv[4], vv[5]); w.w = pk2(vv[6], vv[7]); *(LAS v4u*)(lds + L_VTT + j * PB + tg * 16) = w;
        if (tg == 0) P.GC[(size_t)ch * 64 + j] = fexp2(tot);
    }
    LDS_SYNC();
    {
        const int h = lane >> 5, col = lane & 31;
        for (int T = wave; T < 12; T += 8) {
            const int mat = T / 3, tile = T % 3, tt = tile > 0 ? 1 : 0, st = tile > 1 ? 1 : 0;
            LAS const unsigned char* A = lds + ((mat < 2) ? L_AM : L_RM);
            LAS const unsigned char* B = lds + ((mat & 1) ? L_KM : L_BM);
            f32x16 acc = {}; acc = mm_tile(A, B, tt, st, lane, acc);
            const int s = 32 * st + col;
#pragma unroll
            for (int r = 0; r < 16; ++r) {
                const int t = 32 * tt + CROW(r, h);
                if (mat == 0) { ((LAS float*)(lds + L_LP))[t * 64 + (s & 1) * 32 + (s >> 1)] = (s < t) ? acc[r] : 0.f; }
                else {
                    const bool keep = (mat == 1) ? (s < t) : (s <= t);
                    const int base = (mat == 1) ? L_AAK : ((mat == 2) ? L_AQB : L_AQK);
                    *(LAS bf16*)(lds + base + t * PB + s * 2) = (bf16)f2bf(keep ? acc[r] : 0.f);
                }
            }
        }
        if (wave >= 4 && wave < 7) {
            const int base = (wave == 4) ? L_AAK : ((wave == 5) ? L_AQB : L_AQK);
            const v4u z = {0u, 0u, 0u, 0u};
            LAS v4u* p = (LAS v4u*)(lds + base + col * PB + 64 + h * 32); p[0] = z; p[1] = z;
        }
    }
    LDS_SYNC();
    if (wave < 4) {
        const int tt = wave >> 1, vt = wave & 1, h = lane >> 5, col = lane & 31;
        f32x16 acc = {}; acc = mm_tile(lds + L_AAK, lds + L_VTT, tt, vt, lane, acc);
#pragma unroll
        for (int r = 0; r < 16; ++r) ((LAS float*)(lds + L_RHS2))[(32 * tt + CROW(r, h)) * 64 + 32 * vt + col] = acc[r];
    }
    LDS_SYNC();
    if (wave < 4) {
        const int c = 32 * wave + (lane & 31), par = lane >> 5;
        LAS const float* Lp = (LAS const float*)(lds + L_LP) + par * 32;
        float x[32];
#pragma unroll
        for (int i = 0; i < 32; ++i) x[i] = 0.f;
#pragma unroll
        for (int t = 0; t < 64; ++t) {
            float rhs;
            if (wave < 2) rhs = bf2f(*(LAS const bf16*)(lds + L_AM + t * PB + c * 2)); else rhs = ((LAS const float*)(lds + L_RHS2))[t * 64 + (c - 64)];
            float p0 = 0.f, p1 = 0.f;
            constexpr int dummy = 0; (void)dummy;
            const int nq = ((t + 1) / 2 + 3) / 4;
#pragma unroll
            for (int q = 0; q < 8; ++q) if (q < nq) {
                const f32x4 l4 = *(LAS const f32x4*)(Lp + t * 64 + 4 * q);
                p0 += l4[0] * x[4 * q]; p1 += l4[1] * x[4 * q + 1]; p0 += l4[2] * x[4 * q + 2]; p1 += l4[3] * x[4 * q + 3];
            }
            const float p = p0 + p1;
            const float xt = rhs + p + __shfl_xor(p, 32);
            if ((t & 1) == par) { x[t >> 1] = xt; *(LAS bf16*)(lds + L_XT + c * PB + t * 2) = (bf16)f2bf(xt); }
        }
    }
    LDS_SYNC();
    {
        const int w4 = wave & 3, mt = w4 >> 1, nt = w4 & 1, h = lane >> 5, col = lane & 31;
        if (wave < 4) {
            f32x16 acc = {}; acc = mm_tile(lds + L_AQB, lds + L_XT, mt, nt, lane, acc);
            bf16* qp = P.QP + (size_t)ch * 4096;
#pragma unroll
            for (int r = 0; r < 16; ++r) { const int t = 32 * mt + CROW(r, h), j = 32 * nt + col;
                qp[t * 64 + j] = (bf16)f2bf(acc[r] + bf2f(*(LAS const bf16*)(lds + L_RM + t * PB + j * 2))); }
            f32x16 pm = {}; pm = mm_tile(lds + L_BHT, lds + L_XT, mt, nt, lane, pm);
            bf16* pmp = P.PM + (size_t)ch * 4096;
#pragma unroll
            for (int r = 0; r < 16; ++r) { const int i = 32 * mt + CROW(r, h), j = 32 * nt + col;
                const int i4 = i >> 4, m = i & 15, ks = j >> 5, e = ((j >> 4) & 1) * 4 + (j & 3), q = (j >> 2) & 3;
                pmp[((i4 * 2 + ks) * 64 + q * 16 + m) * 8 + e] = (bf16)f2bf(pm[r]); }
        } else {
            f32x16 acc = {}; acc = mm_tile(lds + L_AQB, lds + L_XT + 64 * PB, mt, nt, lane, acc); acc = mm_tile(lds + L_AQK, lds + L_VTT, mt, nt, lane, acc);
            bf16* y0 = P.Y0 + (size_t)ch * 4096;
#pragma unroll
            for (int r = 0; r < 16; ++r) { const int t = 32 * mt + CROW(r, h), v = 32 * nt + col; y0[t * 64 + v] = (bf16)f2bf(acc[r]); }
            f32x16 gm = {}; gm = mm_tile(lds + L_BHT, lds + L_XT + 64 * PB, mt, nt, lane, gm); gm = mm_tile(lds + L_KHT, lds + L_VTT, mt, nt, lane, gm);
            float* gmp = P.GM + (size_t)ch * 4096;
#pragma unroll
            for (int r = 0; r < 16; ++r) { const int i = 32 * mt + CROW(r, h), v = 32 * nt + col;
                const int sl = v >> 4, n = v & 15, i4 = i >> 4, q = (i >> 2) & 3, reg = i & 3;
                gmp[((sl * 4 + i4) * 64 + q * 16 + n) * 4 + reg] = gm[r]; }
        }
    }
    LDS_SYNC();
}
__device__ __forceinline__ void vt_item(const bf16* QKV, bf16* VT, int item, LAS unsigned char* scr, int lane) {
    const int tb = item >> 4, hd = item & 15;
    const bf16* src = QKV + (size_t)(64 * tb) * QKVW + 2048 + 64 * hd;
#pragma unroll
    for (int i = 0; i < 8; ++i) {
        const int t = i * 8 + (lane >> 3), p = lane & 7;
        const v4u v = *(const v4u*)(src + (size_t)t * QKVW + 8 * p);
        const unsigned w[4] = {v.x, v.y, v.z, v.w};
#pragma unroll
        for (int e = 0; e < 8; ++e) *(LAS bf16*)(scr + (8 * p + e) * PB + t * 2) = (bf16)((w[e >> 1] >> ((e & 1) * 16)) & 0xffffu);
    }
    LDS_WAIT(); asm volatile("" ::: "memory");
#pragma unroll
    for (int i = 0; i < 8; ++i) {
        const int d = i * 8 + (lane >> 3), p = lane & 7;
        const v4u v = *(LAS const v4u*)(scr + d * PB + p * 16);
        *(v4u*)(VT + (size_t)(64 * hd + d) * MP + 64 * tb + 8 * p) = v;
    }
    LDS_WAIT(); asm volatile("" ::: "memory");
}
__device__ __forceinline__ void samp_kv_item(const bf16* QKV, bf16* KS, bf16* VST, int item, int lane) {
    const int b = item >> 4, cbk = item & 15, col = 64 * cbk + lane;
    unsigned short kv[16], vv[16];
#pragma unroll
    for (int s = 0; s < 16; ++s) { const bf16* rp = QKV + (size_t)(MP + 16 * b + s) * QKVW; kv[s] = rp[1024 + col]; vv[s] = rp[2048 + col]; }
    bf16* ks = KS + ((size_t)b * KSROWS + 512) * 1024 + col;
#pragma unroll
    for (int s = 0; s < 16; ++s) { ks[(size_t)s * 1024] = kv[s]; ks[(size_t)(16 + s) * 1024] = 0; }
    v4u w0, w1; const v4u z = {0u, 0u, 0u, 0u};
    w0.x = (unsigned)vv[0] | ((unsigned)vv[1] << 16); w0.y = (unsigned)vv[2] | ((unsigned)vv[3] << 16); w0.z = (unsigned)vv[4] | ((unsigned)vv[5] << 16); w0.w = (unsigned)vv[6] | ((unsigned)vv[7] << 16);
    w1.x = (unsigned)vv[8] | ((unsigned)vv[9] << 16); w1.y = (unsigned)vv[10] | ((unsigned)vv[11] << 16); w1.z = (unsigned)vv[12] | ((unsigned)vv[13] << 16); w1.w = (unsigned)vv[14] | ((unsigned)vv[15] << 16);
    v4u* vp = (v4u*)(VST + ((size_t)b * 1024 + col) * KSROWS + 512);
    vp[0] = w0; vp[1] = w1; vp[2] = z; vp[3] = z;
}

struct ScanParams { const bf16* PM; const float* GM; const float* GC; bf16* S0; const float* wkv_in; float* out; };
struct ScanFrag { bf16x8 pm[4][2]; f32x4 gm[4]; f32x4 gc[4]; };
__device__ __forceinline__ void scan_load(ScanFrag& F, const ScanParams& P, int ch, int sl, int lane) {
    const bf16* pm = P.PM + (size_t)ch * 4096 + lane * 8; const float* gm = P.GM + (size_t)ch * 4096 + (sl * 4 * 64 + lane) * 4; const float* gc = P.GC + (size_t)ch * 64 + 4 * (lane >> 4);
#pragma unroll
    for (int i4 = 0; i4 < 4; ++i4) { F.pm[i4][0] = *(const bf16x8*)(pm + (i4 * 2) * 512); F.pm[i4][1] = *(const bf16x8*)(pm + (i4 * 2 + 1) * 512);
        F.gm[i4] = *(const f32x4*)(gm + i4 * 256); F.gc[i4] = *(const f32x4*)(gc + 16 * i4); }
}
__device__ __forceinline__ void scan_task(const ScanParams& P, int seq, int sl, int lane) {
    const int n = lane & 15, q = lane >> 4, v = 16 * sl + n;
    const bool samp = seq >= 16; const int nsteps = samp ? 1 : 128;
    float* fin = samp ? P.out + OFF_WKVS + (size_t)(seq - 16) * 4096 : P.out + OFF_WKVP + (size_t)seq * 4096;
    f32x4 acc[4];
#pragma unroll
    for (int i4 = 0; i4 < 4; ++i4) acc[i4] = samp ? *(const f32x4*)(P.wkv_in + (size_t)(seq - 16) * 4096 + v * 64 + 16 * i4 + 4 * q) : (f32x4){0.f, 0.f, 0.f, 0.f};
    ScanFrag cur, nxt;
    int ch = samp ? NCH_P + (seq - 16) : seq;
    scan_load(cur, P, ch, sl, lane);
    for (int st = 0; st < nsteps; ++st) {
        const int chn = ch + 16;
        if (st + 1 < nsteps) scan_load(nxt, P, chn, sl, lane);
        v2u p[4];
#pragma unroll
        for (int i4 = 0; i4 < 4; ++i4) { p[i4].x = pk2(acc[i4][0], acc[i4][1]); p[i4].y = pk2(acc[i4][2], acc[i4][3]); }
        bf16* s0 = P.S0 + (size_t)ch * 4096 + v * 64 + 4 * q;
#pragma unroll
        for (int i4 = 0; i4 < 4; ++i4) *(v2u*)(s0 + 16 * i4) = p[i4];
        const v4u b0u = {p[0].x, p[0].y, p[1].x, p[1].y}, b1u = {p[2].x, p[2].y, p[3].x, p[3].y};
        const bf16x8 b0 = __builtin_bit_cast(bf16x8, b0u), b1 = __builtin_bit_cast(bf16x8, b1u);
#pragma unroll
        for (int i4 = 0; i4 < 4; ++i4) {
            f32x4 d = mfma16(cur.pm[i4][0], b0, cur.gm[i4]); d = mfma16(cur.pm[i4][1], b1, d);
            acc[i4] = cur.gc[i4] * acc[i4] + d;
        }
        if (st + 1 < nsteps) { cur = nxt; ch = chn; }
    }
#pragma unroll
    for (int i4 = 0; i4 < 4; ++i4) *(f32x4*)(fin + v * 64 + 16 * i4 + 4 * q) = acc[i4];
}

struct S4Params { const bf16 *S0, *QP, *Y0, *GG, *BN; const float *lnx_w, *lnx_b; bf16* mix; };
__device__ __forceinline__ void stage4_task(const S4Params& P, int item, int lane) {
    const int ch = item >> 1, tt = item & 1; const bool samp = ch >= NCH_P; const int hd = ch & 15;
    if (samp && tt == 1) return;
    const int cbi = samp ? (ch - NCH_P) >> 4 : ch >> 4; const int row0 = samp ? MP + 16 * cbi : 64 * cbi; const int nvalid = samp ? 16 : 64;
    const int l31 = lane & 31, h = lane >> 5, t = 32 * tt + l31;
    const bf16* s0 = P.S0 + (size_t)ch * 4096; const bf16* qp = P.QP + (size_t)ch * 4096 + t * 64 + 8 * h;
    f32x16 acc[2] = {};
#pragma unroll
    for (int s = 0; s < 4; ++s) {
        const bf16x8 b = *(const bf16x8*)(qp + 16 * s);
#pragma unroll
        for (int vt = 0; vt < 2; ++vt) acc[vt] = mfma32(*(const bf16x8*)(s0 + (32 * vt + l31) * 64 + 16 * s + 8 * h), b, acc[vt]);
    }
    const bf16* y0 = P.Y0 + (size_t)ch * 4096 + t * 64; const bf16* gg = P.GG + (size_t)ch * 4096 + t * 64; const bf16* bn = P.BN + (size_t)ch * 4096 + t * 64;
    float y[2][16]; float s1 = 0.f;
#pragma unroll
    for (int vt = 0; vt < 2; ++vt)
#pragma unroll
        for (int g = 0; g < 4; ++g) { const v2u w = *(const v2u*)(y0 + 32 * vt + 8 * g + 4 * h);
            y[vt][4 * g + 0] = acc[vt][4 * g + 0] + bflo(w.x); y[vt][4 * g + 1] = acc[vt][4 * g + 1] + bfhi(w.x); y[vt][4 * g + 2] = acc[vt][4 * g + 2] + bflo(w.y); y[vt][4 * g + 3] = acc[vt][4 * g + 3] + bfhi(w.y);
            s1 += (y[vt][4 * g] + y[vt][4 * g + 1]) + (y[vt][4 * g + 2] + y[vt][4 * g + 3]); }
    s1 += __shfl_xor(s1, 32);
    const float mean = s1 * (1.f / 64.f); float s2 = 0.f;
#pragma unroll
    for (int vt = 0; vt < 2; ++vt)
#pragma unroll
        for (int r = 0; r < 16; ++r) { const float d = y[vt][r] - mean; s2 += d * d; }
    s2 += __shfl_xor(s2, 32);
    const float rstd = __builtin_amdgcn_rsqf(s2 * (1.f / 64.f) + GN_EPS);
    if (l31 + 32 * tt < nvalid) {
        bf16* op = P.mix + (size_t)(row0 + t) * DM + 1024 + 64 * hd;
#pragma unroll
        for (int vt = 0; vt < 2; ++vt)
#pragma unroll
            for (int g = 0; g < 4; ++g) { const int v0 = 32 * vt + 8 * g + 4 * h;
                const f32x4 lw = *(const f32x4*)(P.lnx_w + 64 * hd + v0), lb = *(const f32x4*)(P.lnx_b + 64 * hd + v0);
                const v2u gw = *(const v2u*)(gg + v0), bw = *(const v2u*)(bn + v0);
                const float gv[4] = {bflo(gw.x), bfhi(gw.x), bflo(gw.y), bfhi(gw.y)}, bv[4] = {bflo(bw.x), bfhi(bw.x), bflo(bw.y), bfhi(bw.y)};
                float o[4];
#pragma unroll
                for (int e = 0; e < 4; ++e) o[e] = ((y[vt][4 * g + e] - mean) * rstd * lw[e] + lb[e] + bv[e]) * gv[e];
                v2u w; w.x = pk2(o[0], o[1]); w.y = pk2(o[2], o[3]); *(v2u*)(op + v0) = w; }
    }
}

struct AttnParams { const bf16 *QKV, *VT, *KS, *VST; bf16* mix; };
__device__ __forceinline__ int swap23(int r) { return (r & ~12) | ((r & 4) << 1) | ((r & 8) >> 1); }
__device__ __forceinline__ void attn_unit(const AttnParams& P, int unit, LAS const float* tbl, int lane) {
    const int q = lane & 31, h = lane >> 5;
    int hd, qrow0, nq, qpos0, kt0, kt1, nkeys; const bf16 *Kb, *Vb; size_t kpitch, vpitch;
    if (unit < 4096) { const int c = unit >> 5, qh = unit & 1; hd = (unit >> 1) & 15;
        qrow0 = 64 * c + 32 * qh; nq = 32; qpos0 = qrow0; Kb = P.QKV + 1024 + 64 * hd; kpitch = QKVW; Vb = P.VT + (size_t)(64 * hd) * MP; vpitch = MP;
        kt0 = c >= 8 ? 64 * (c - 8) : 0; kt1 = 64 * c + 64; nkeys = kt1;
    } else { const int u2 = unit - 4096, b = u2 >> 4; hd = u2 & 15;
        qrow0 = MP + 16 * b; nq = 16; qpos0 = 512; Kb = P.KS + (size_t)b * KSROWS * 1024 + 64 * hd; kpitch = 1024; Vb = P.VST + ((size_t)b * 1024 + 64 * hd) * KSROWS; vpitch = KSROWS;
        kt0 = 0; kt1 = KSROWS; nkeys = 528;
    }
    const int qv = q < nq ? q : nq - 1;
    const bf16* qp = P.QKV + (size_t)(qrow0 + qv) * QKVW + 64 * hd + 8 * h;
    bf16x8 qf[4];
#pragma unroll
    for (int s = 0; s < 4; ++s) qf[s] = *(const bf16x8*)(qp + 16 * s);
    LAS const float* tb = tbl + hd * 257;
    const int qpos = qpos0 + q;
    float m = -1e30f, l = 0.f; f32x16 o[2] = {};
    const int kr = swap23(q);
    for (int kb = kt0; kb < kt1; kb += 32) {
        const bf16* kp = Kb + (size_t)(kb + kr) * kpitch + 8 * h;
        bf16x8 kf[4], vf[2][2];
#pragma unroll
        for (int s = 0; s < 4; ++s) kf[s] = *(const bf16x8*)(kp + 16 * s);
#pragma unroll
        for (int dt = 0; dt < 2; ++dt)
#pragma unroll
            for (int s = 0; s < 2; ++s) vf[dt][s] = *(const bf16x8*)(Vb + (size_t)(32 * dt + q) * vpitch + kb + 16 * s + 8 * h);
        f32x16 st = {};
#pragma unroll
        for (int s = 0; s < 4; ++s) st = mfma32(kf[s], qf[s], st);
        float sc[16]; float mx = -1e30f;
#pragma unroll
        for (int r = 0; r < 16; ++r) {
            const int kpos = kb + 16 * (r >> 3) + 8 * h + (r & 7);
            int dist = qpos - kpos; dist = dist < -128 ? -128 : (dist > 128 ? 128 : dist);
            float s = st[r] + tb[dist + 128];
            if (kpos >= nkeys) s = -1e30f;
            sc[r] = s; mx = fmaxf(mx, s);
        }
        mx = fmaxf(mx, __shfl_xor(mx, 32));
        const float mn = fmaxf(m, mx), alpha = fexp2(m - mn); m = mn;
        float ps = 0.f;
#pragma unroll
        for (int r = 0; r < 16; ++r) { sc[r] = fexp2(sc[r] - mn); ps += sc[r]; }
        l = l * alpha + ps;
#pragma unroll
        for (int dt = 0; dt < 2; ++dt)
#pragma unroll
            for (int r = 0; r < 16; ++r) o[dt][r] *= alpha;
        v4u pa, pb;
        pa.x = pk2(sc[0], sc[1]); pa.y = pk2(sc[2], sc[3]); pa.z = pk2(sc[4], sc[5]); pa.w = pk2(sc[6], sc[7]);
        pb.x = pk2(sc[8], sc[9]); pb.y = pk2(sc[10], sc[11]); pb.z = pk2(sc[12], sc[13]); pb.w = pk2(sc[14], sc[15]);
        const bf16x8 pf0 = __builtin_bit_cast(bf16x8, pa), pf1 = __builtin_bit_cast(bf16x8, pb);
#pragma unroll
        for (int dt = 0; dt < 2; ++dt) { o[dt] = mfma32(vf[dt][0], pf0, o[dt]); o[dt] = mfma32(vf[dt][1], pf1, o[dt]); }
    }
    l += __shfl_xor(l, 32);
    const float inv = frcp(l);
    if (q < nq) {
        bf16* op = P.mix + (size_t)(qrow0 + q) * DM + 64 * hd;
#pragma unroll
        for (int dt = 0; dt < 2; ++dt)
#pragma unroll
            for (int g = 0; g < 4; ++g) { v2u w; w.x = pk2(o[dt][4 * g] * inv, o[dt][4 * g + 1] * inv); w.y = pk2(o[dt][4 * g + 2] * inv, o[dt][4 * g + 3] * inv);
                *(v2u*)(op + 32 * dt + 8 * g + 4 * h) = w; }
    }
}
__global__ void __launch_bounds__(NTHREADS, 2) mega_fwd(Args args) {
    extern __shared__ __attribute__((aligned(16))) unsigned char lds_raw[];
    LAS unsigned char* lds = (LAS unsigned char*)lds_raw;
    volatile LAS unsigned* MISC = (volatile LAS unsigned*)(lds + MISC_OFF);
    const int tid = threadIdx.x, lane = tid & 63, wave = __builtin_amdgcn_readfirstlane(tid >> 6);
    const int G = gridDim.x, bx = blockIdx.x;
    const int vcu = (G % 8 == 0) ? (bx % 8) * (G / 8) + bx / 8 : bx;
    const int gw = vcu * NWAVES + wave, NGW = G * NWAVES;
    unsigned char* ws = args.ws; float* out = args.out;
    gu32* ctl = (gu32*)(ws + WS_CTL);
    const float *x_p = args.in[0], *x_s = args.in[1], *cache_k = args.in[2], *cache_v = args.in[3], *wkv_in = args.in[4], *shift_in = args.in[5],
                *ln1 = args.in[6], *w_in = args.in[7], *rel_table = args.in[8], *mu = args.in[9], *w0 = args.in[10], *w_w2 = args.in[11], *a0 = args.in[12],
                *a_w2 = args.in[13], *g_w2 = args.in[14], *k_k = args.in[15], *k_a = args.in[16], *r_k = args.in[17], *lnx_w = args.in[18], *lnx_b = args.in[19],
                *w_o = args.in[20], *ln2 = args.in[21], *w_gate = args.in[22], *w_up = args.in[23], *w_down = args.in[24], *final_norm = args.in[25];
    bf16 *W1T = (bf16*)(ws + WS_W1T), *W2T = (bf16*)(ws + WS_W2T), *LWT = (bf16*)(ws + WS_LORA), *LAT = LWT + 1024 * 64, *LGT = LAT + 1024 * 64;
    bf16 *A1 = (bf16*)(ws + WS_A1), *QKV = (bf16*)(ws + WS_QKV), *Z = (bf16*)(ws + WS_Z), *KS = (bf16*)(ws + WS_KS), *VST = (bf16*)(ws + WS_VST), *VT = (bf16*)(ws + WS_VT);
    bf16 *HB = (bf16*)(ws + WS_HB), *W3T = (bf16*)(ws + WS_W3T), *W4T = (bf16*)(ws + WS_W4T), *FF = (bf16*)(ws + WS_FF), *MIX = A1;
    bf16 *PM = (bf16*)(ws + WS_RW + RW_PM), *Y0 = (bf16*)(ws + WS_RW + RW_Y0), *GG = (bf16*)(ws + WS_RW + RW_GG), *BN = (bf16*)(ws + WS_RW + RW_BN), *S0 = (bf16*)(ws + WS_RW + RW_S0);
    float* GC = (float*)(ws + WS_RW + RW_GC);
    float* GM = (float*)((unsigned char*)out + DO_GM); bf16* QP = (bf16*)((unsigned char*)out + DO_QP);
    float* ssq2 = (float*)(ws + WS_CTL) + CW_SSQ2; float* ssq3 = (float*)(ws + WS_CTL) + CW_SSQ3;

    for (int u = tid; u < (LDS_BYTES - LDSCTL_OFF) / 4; u += NTHREADS) ((LAS unsigned*)(lds + LDSCTL_OFF))[u] = 0u;
    __syncthreads();
    XcdBarrier bar = xcd_barrier_post((unsigned*)(ctl + CW_BAR), MISC + 8);
#define GRID_BAR() xcd_barrier(bar)

    {
        P0Params P{x_p, x_s, cache_k, cache_v, ln1, w_in, w_w2, a_w2, g_w2, w_o, W1T, W2T, LWT, LAT, LGT, A1, KS, VST};
        p0_prologue(P, lds, gw, NGW, wave, lane);
    }
    GRID_BAR();
    {
        pg8::Gemm g{A1, W1T, MROWS, INW, DM}; pg8::StaticOrder S; S.init(MROWS, INW, G, bx);
        EpiG1 E{QKV, Z, out};
        pg8::gemm_phase<EpiG1, pg8::StaticOrder, true, true>(lds, g, S, E);
    }
    GRID_BAR();
    {
        LAS unsigned char* scr = lds + wave * 9216;
        for (int it = gw; it < 2048; it += NGW) vt_item(QKV, VT, it, scr, lane);
        for (int it = gw; it < 256; it += NGW) samp_kv_item(QKV, KS, VST, it, lane);
        BLK_SYNC();
        RwkvParams P{Z, shift_in, mu, w0, a0, k_k, k_a, r_k, LWT, LAT, LGT, PM, Y0, GG, BN, QP, GM, GC};
        for (int ch = vcu; ch < NCH; ch += G) rwkv_chunk(P, ch, lds, tid, wave, lane);
    }
    GRID_BAR();
    {
        LAS float* tbl = (LAS float*)lds;
        for (int i = tid; i < 16 * 257; i += NTHREADS) tbl[i] = rel_table[i] * LOG2E;
        LDS_SYNC();
        ScanParams SP{PM, GM, GC, S0, wkv_in, out};
        AttnParams AP{QKV, VT, KS, VST, MIX};
        constexpr int N_LONG = 64, N_ATT = 4096 + 256, N_SHORT = 1024, N_ALL = N_LONG + N_ATT + N_SHORT;
        for (;;) {
            int it = 0;
            if (lane == 0) it = (int)__hip_atomic_fetch_add(ctl + CW_QATT, 1u, RLX_AGENT);
            it = __builtin_amdgcn_readfirstlane(it);
            if (it >= N_ALL) break;
            if (it < N_LONG) scan_task(SP, it >> 2, it & 3, lane);
            else if (it < N_LONG + N_ATT) attn_unit(AP, it - N_LONG, tbl, lane);
            else { const int s = it - N_LONG - N_ATT; scan_task(SP, 16 + (s >> 2), s & 3, lane); }
        }
    }
    GRID_BAR();
    {
        S4Params P{S0, QP, Y0, GG, BN, lnx_w, lnx_b, MIX};
        for (int it = gw; it < 2 * NCH; it += NGW) stage4_task(P, it, lane);
    }
    GRID_BAR();
    {
        pg8::Gemm g{MIX, W2T, MROWS, DM, DM}; pg8::StaticOrder S; S.init(MROWS, DM, G, bx);
        EpiG2 E{x_p, x_s, out, HB, ssq2};
        pg8::gemm_phase<EpiG2, pg8::StaticOrder, true, true>(lds, g, S, E);
        BLK_SYNC();
        LAS float* scr = (LAS float*)(lds + wave * 16384);
        constexpr int I_G = (DM / 64) * (DFF / 32), I_D = (DFF / 64) * (DM / 32), N_CONV = 2 * I_G + I_D;
        for (;;) {
            int it = 0;
            if (lane == 0) it = (int)__hip_atomic_fetch_add(ctl + CW_QCONV, 1u, RLX_AGENT);
            it = __builtin_amdgcn_readfirstlane(it);
            if (it >= N_CONV) break;
            if (it < 2 * I_G) { const bool up = it >= I_G; const int r = up ? it - I_G : it; const int nb = DFF / 32, kb = r / nb, n0 = 32 * (r % nb);
                tr_item(up ? w_up : w_gate, DFF, W3T, DM, 64 * kb, n0, 256 * (n0 >> 7) + (n0 & 127) + (up ? 128 : 0), ln2, scr, lane); }
            else { const int r = it - 2 * I_G; const int nb = DM / 32; tr_item(w_down, DM, W4T, DFF, 64 * (r / nb), 32 * (r % nb), 32 * (r % nb), nullptr, scr, lane); }
        }
    }
    GRID_BAR();
    {
        pg8::Gemm g{HB, W3T, MROWS, 2 * DFF, DM}; pg8::StaticOrder S; S.init(MROWS, 2 * DFF, G, bx);
        EpiG3 E{ssq2, FF};
        pg8::gemm_phase<EpiG3, pg8::StaticOrder, true, true>(lds, g, S, E);
    }
    GRID_BAR();
    {
        pg8::Gemm g{FF, W4T, MROWS, DM, DFF}; pg8::StaticOrder S; S.init(MROWS, DM, G, bx);
        EpiG4 E{out, ssq3};
        pg8::gemm_phase<EpiG4, pg8::StaticOrder, true, true>(lds, g, S, E);
    }
    GRID_BAR();
    for (int m = gw; m < MROWS; m += NGW) final_norm_row(out + (size_t)m * DM, final_norm, ssq3[m], lane);
}

extern "C" void kernel_launch(void* const* d_in, const int* in_sizes, int n_in, void* d_out, int out_size, void* d_ws, size_t ws_size, hipStream_t stream) {
    static int grid = 0;
    if (grid == 0) {
        if (n_in != 26 || (size_t)out_size != OUT_TOTAL || ws_size < WS_END) { fprintf(stderr, "kernel_launch: unexpected shapes (n_in %d, out %d, ws %zu < %zu)\n", n_in, out_size, ws_size, (size_t)WS_END); grid = -1; return; }
        int dev = 0, cus = 0;
        if (hipGetDevice(&dev) != hipSuccess || hipDeviceGetAttribute(&cus, hipDeviceAttributeMultiprocessorCount, dev) != hipSuccess) { grid = -1; return; }
        if (hipFuncSetAttribute((const void*)mega_fwd, hipFuncAttributeMaxDynamicSharedMemorySize, LDS_BYTES) != hipSuccess) { fprintf(stderr, "kernel_launch: hipFuncSetAttribute failed\n"); grid = -1; return; }
        (void)hipGetLastError();
        grid = cus;
    }
    if (grid < 0) return;
    if (hipMemsetAsync((char*)d_ws + WS_CTL, 0, CTL_BYTES, stream) != hipSuccess) return;
    Args a{};
    for (int i = 0; i < 26; ++i) a.in[i] = (const float*)d_in[i];
    a.out = (float*)d_out; a.ws = (unsigned char*)d_ws;
    hipLaunchKernelGGL(mega_fwd, dim3(grid), dim3(NTHREADS), LDS_BYTES, stream, a);
}
```

```cpp
#include <hip/hip_runtime.h>
#include <cstdio>
#include <cstdint>
namespace pg8 {
#define PG8_LAS __attribute__((address_space(3)))
typedef unsigned short bf16_t;
typedef short bf16x8 __attribute__((ext_vector_type(8)));
typedef float f32x4 __attribute__((ext_vector_type(4)));
typedef unsigned u32x4 __attribute__((ext_vector_type(4)));
constexpr int BM = 256, BK = 64, HALF = 128, HTB = HALF * BK * 2, STAGE_BYTES = 8 * HTB, NXCD = 8, WGM = 8;

__host__ __device__ __forceinline__ int lds_byte(int r, int c) { const int st = (r >> 4) * 2 + (c >> 5), rr = r & 15, cc = c & 31, ob = rr * 64 + cc * 2; return st * 1024 + (ob ^ (((ob >> 9) & 1) << 5)); }
__host__ __device__ __forceinline__ void stage_rc(int b, int& R, int& C) { const int st = b / 1024, sb = b % 1024, swz = sb ^ (((sb >> 9) & 1) << 5); R = (st >> 1) * 16 + swz / 64; C = (st & 1) * 32 + (swz % 64) / 2; }
__host__ __device__ __forceinline__ int perm32(int rho) { const int n = rho >> 4, i = rho & 15; return 8 * (i >> 2) + 4 * n + (i & 3); }

struct Unit { int pm, pn, k0, nk; };
struct Gemm { const bf16_t* A; const bf16_t* Bt; int M, N, K; };

struct StaticOrder {
    int nM, nN, nwg, G, c, nkf;
    __host__ __device__ void init(int M, int N, int K, int G_, int c_) { nM = M / BM; nN = N / BM; nwg = nM * nN; G = G_; c = c_; nkf = K / BK; }
    __host__ __device__ bool next(int i, Unit& u) const {
        const long L = (long)i * G + c; if (L >= nwg) return false;
        int wgid = (int)L; { const int q = nwg / NXCD, r = nwg % NXCD, xcd = wgid % NXCD, off = wgid / NXCD; wgid = (xcd < r ? xcd * (q + 1) : r * (q + 1) + (xcd - r) * q) + off; }
        const int nig = WGM * nN, gid = wgid / nig, fm = gid * WGM, gsz = (nM - fm) < WGM ? (nM - fm) : WGM;
        u.pm = fm + ((wgid % nig) % gsz); u.pn = (wgid % nig) / gsz; u.k0 = 0; u.nk = nkf; return true;
    }
};

template <class Epi, class Sched, bool ALIGN_EPI = false, bool SP2 = false>
__device__ __forceinline__ void gemm_phase(PG8_LAS unsigned char* lds, const Gemm g, const Sched& S, const Epi& E) {
    const int tid = threadIdx.x, wid = __builtin_amdgcn_readfirstlane(tid >> 6), lane = tid & 63, wr = wid >> 2, wc = wid & 3, fr = lane & 15, fq = lane >> 4;
    const int K = g.K;
    unsigned voffA[2], voffB[2];
#pragma unroll
    for (int i = 0; i < 2; ++i) { int R, C; stage_rc(tid * 16 + i * 8192, R, C); const int Rb = Epi::PERM ? ((R & ~31) + perm32(R & 31)) : R;
        voffA[i] = (unsigned)(R * K + C) * 2u; voffB[i] = (unsigned)(Rb * K + C) * 2u; }
    const size_t kstep = (size_t)(BK * 2);
    const size_t hstep = (size_t)HALF * K * 2;
    const size_t tstep = 2 * hstep;
    const unsigned ldsw = (unsigned)wid * 1024u;
    const int aoff = lds_byte(wr * 64 + fr, fq * 8), boff = lds_byte(wc * 32 + fr, fq * 8);
#define PG8_SA(b, h) (((b) * 2 + (h)) * HTB)
#define PG8_SB(b, h) ((4 + (b) * 2 + (h)) * HTB)
#define PG8_STAGE(bufoff, gbase, voff) do { _Pragma("unroll") for (int _i = 0; _i < 2; ++_i) \
        __builtin_amdgcn_global_load_lds((const unsigned*)((const char*)(gbase) + (voff)[_i]), (PG8_LAS unsigned*)(lds + (bufoff) + ldsw + _i * 8192), 16, 0, 0); } while (0)
#define PG8_LDA(dst, b, h) do { _Pragma("unroll") for (int m = 0; m < 4; ++m) _Pragma("unroll") for (int k = 0; k < 2; ++k) dst[m][k] = *(const PG8_LAS bf16x8*)(lds + PG8_SA(b, h) + aoff + m * 2048 + k * 1024); } while (0)
#define PG8_LDB(dst, b, h) do { _Pragma("unroll") for (int n = 0; n < 2; ++n) _Pragma("unroll") for (int k = 0; k < 2; ++k) dst[n][k] = *(const PG8_LAS bf16x8*)(lds + PG8_SB(b, h) + boff + n * 2048 + k * 1024); } while (0)
#define PG8_MMA(ai, bj, At, Bt) do { __builtin_amdgcn_s_setprio(1); _Pragma("unroll") for (int m = 0; m < 4; ++m) _Pragma("unroll") for (int n = 0; n < 2; ++n) _Pragma("unroll") for (int k = 0; k < 2; ++k) \
        acc[ai][bj][m][n] = __builtin_amdgcn_mfma_f32_16x16x32_bf16(Bt[n][k], At[m][k], acc[ai][bj][m][n], 0, 0, 0); __builtin_amdgcn_s_setprio(0); } while (0)
#define PG8_WAIT_V(n) asm volatile("s_waitcnt vmcnt(" #n ")" ::: "memory")
#define PG8_WAIT_L(n) asm volatile("s_waitcnt lgkmcnt(" #n ")" ::: "memory")
#define PG8_BAR __builtin_amdgcn_s_barrier()
#define PG8_SCHED __builtin_amdgcn_sched_barrier(0)
    Unit cur, nxt; int ui = 0;
    if (!S.next(0, cur)) return;
    f32x4 acc[2][2][4][2];
#pragma unroll
    for (int a = 0; a < 2; ++a)
#pragma unroll
        for (int b = 0; b < 2; ++b)
#pragma unroll
            for (int m = 0; m < 4; ++m)
#pragma unroll
                for (int n = 0; n < 2; ++n) acc[a][b][m][n] = (f32x4){0.f, 0.f, 0.f, 0.f};
    bf16x8 At[4][2], B0[2][2], B1[2][2];
    const char* cA = (const char*)g.A + (size_t)cur.pm * tstep + (size_t)cur.k0 * kstep; const char* cB = (const char*)g.Bt + (size_t)cur.pn * tstep + (size_t)cur.k0 * kstep;
    if constexpr (SP2) {
        PG8_STAGE(PG8_SB(0, 0), cB, voffB); PG8_STAGE(PG8_SB(0, 1), cB + hstep, voffB); PG8_STAGE(PG8_SA(0, 0), cA, voffA); PG8_STAGE(PG8_SA(0, 1), cA + hstep, voffA);
        if (wr == 1) PG8_BAR;
        PG8_WAIT_V(2); PG8_BAR;
        PG8_STAGE(PG8_SB(1, 0), cB + kstep, voffB); PG8_STAGE(PG8_SA(1, 0), cA + kstep, voffA); PG8_STAGE(PG8_SB(1, 1), cB + hstep + kstep, voffB);
        PG8_WAIT_V(6); PG8_BAR;
    } else {
        PG8_STAGE(PG8_SB(0, 0), cB, voffB); PG8_STAGE(PG8_SA(0, 0), cA, voffA); PG8_STAGE(PG8_SB(0, 1), cB + hstep, voffB); PG8_STAGE(PG8_SA(0, 1), cA + hstep, voffA);
        if (wr == 1) PG8_BAR;
        PG8_WAIT_V(4); PG8_BAR;
        PG8_STAGE(PG8_SB(1, 0), cB + kstep, voffB); PG8_STAGE(PG8_SA(1, 0), cA + kstep, voffA); PG8_STAGE(PG8_SB(1, 1), cB + hstep + kstep, voffB);
        PG8_WAIT_V(6); PG8_BAR;
    }
    for (;;) {
        const bool has_next = S.next(ui + 1, nxt);
        const char* nA = has_next ? (const char*)g.A + (size_t)nxt.pm * tstep + (size_t)nxt.k0 * kstep : cA; const char* nB = has_next ? (const char*)g.Bt + (size_t)nxt.pn * tstep + (size_t)nxt.k0 * kstep : cB;
        const int nt = cur.nk;
        for (int t = 0; t < nt; t += 2) {
            const bool last = (t == nt - 2);
            const char* a1 = cA + (size_t)(t + 1) * kstep;
            const char* a2 = last ? nA : cA + (size_t)(t + 2) * kstep; const char* b2 = last ? nB : cB + (size_t)(t + 2) * kstep;
            const char* a3 = a2 + kstep; const char* b3 = b2 + kstep;
            if constexpr (SP2) {
            PG8_LDB(B0, 0, 0); PG8_LDB(B1, 0, 1); PG8_SCHED; PG8_LDA(At, 0, 0); PG8_STAGE(PG8_SA(1, 1), a1 + hstep, voffA);
            PG8_WAIT_V(8); PG8_WAIT_L(0); PG8_BAR; PG8_MMA(0, 0, At, B0); PG8_MMA(0, 1, At, B1); PG8_BAR; PG8_SCHED;
            PG8_LDA(At, 0, 1); PG8_STAGE(PG8_SB(0, 0), b2, voffB); PG8_STAGE(PG8_SB(0, 1), b2 + hstep, voffB); PG8_STAGE(PG8_SA(0, 0), a2, voffA);
            PG8_WAIT_V(8); PG8_WAIT_L(0); PG8_BAR; PG8_MMA(1, 0, At, B0); PG8_MMA(1, 1, At, B1); PG8_BAR; PG8_SCHED;
            PG8_LDB(B0, 1, 0); PG8_LDB(B1, 1, 1); PG8_SCHED; PG8_LDA(At, 1, 0); PG8_STAGE(PG8_SA(0, 1), a2 + hstep, voffA);
            PG8_WAIT_V(8); PG8_WAIT_L(0); PG8_BAR; PG8_MMA(0, 0, At, B0); PG8_MMA(0, 1, At, B1); PG8_BAR; PG8_SCHED;
            PG8_LDA(At, 1, 1); PG8_STAGE(PG8_SB(1, 0), b3, voffB); PG8_STAGE(PG8_SB(1, 1), b3 + hstep, voffB); PG8_STAGE(PG8_SA(1, 0), a3, voffA);
            PG8_WAIT_V(8); PG8_WAIT_L(0); PG8_BAR; PG8_MMA(1, 0, At, B0); PG8_MMA(1, 1, At, B1); PG8_BAR; PG8_SCHED;
            } else {
            PG8_LDB(B0, 0, 0); PG8_SCHED; PG8_LDA(At, 0, 0); PG8_STAGE(PG8_SA(1, 1), a1 + hstep, voffA);
            PG8_WAIT_L(8); PG8_BAR; PG8_WAIT_L(0); PG8_MMA(0, 0, At, B0); PG8_BAR; PG8_SCHED;
            PG8_LDB(B1, 0, 1); PG8_STAGE(PG8_SB(0, 0), b2, voffB);
            PG8_BAR; PG8_WAIT_L(0); PG8_MMA(0, 1, At, B1); PG8_BAR;
            PG8_LDA(At, 0, 1); PG8_STAGE(PG8_SA(0, 0), a2, voffA);
            PG8_BAR; PG8_WAIT_L(0); PG8_MMA(1, 0, At, B0); PG8_BAR; PG8_SCHED;
            PG8_STAGE(PG8_SB(0, 1), b2 + hstep, voffB);
            PG8_WAIT_V(6); PG8_BAR; PG8_MMA(1, 1, At, B1); PG8_BAR;
            PG8_LDB(B0, 1, 0); PG8_SCHED; PG8_LDA(At, 1, 0); PG8_STAGE(PG8_SA(0, 1), a2 + hstep, voffA);
            PG8_WAIT_L(8); PG8_BAR; PG8_WAIT_L(0); PG8_MMA(0, 0, At, B0); PG8_BAR; PG8_SCHED;
            PG8_LDB(B1, 1, 1); PG8_STAGE(PG8_SB(1, 0), b3, voffB);
            PG8_BAR; PG8_WAIT_L(0); PG8_MMA(0, 1, At, B1); PG8_BAR;
            PG8_LDA(At, 1, 1); PG8_STAGE(PG8_SA(1, 0), a3, voffA);
            PG8_BAR; PG8_WAIT_L(0); PG8_MMA(1, 0, At, B0); PG8_BAR; PG8_SCHED;
            PG8_STAGE(PG8_SB(1, 1), b3 + hstep, voffB);
            PG8_WAIT_V(6); PG8_BAR; PG8_MMA(1, 1, At, B1); PG8_BAR;
            }
        }
        if constexpr (ALIGN_EPI) { if (wr == 0) PG8_BAR; }
        E(acc, cur, wr, wc, fr, fq);
        if (!has_next) break;
#pragma unroll
        for (int a = 0; a < 2; ++a)
#pragma unroll
            for (int b = 0; b < 2; ++b)
#pragma unroll
                for (int m = 0; m < 4; ++m)
#pragma unroll
                    for (int n = 0; n < 2; ++n) acc[a][b][m][n] = (f32x4){0.f, 0.f, 0.f, 0.f};
        cur = nxt; cA = nA; cB = nB; ++ui;
        if constexpr (ALIGN_EPI) { if (wr == 1) PG8_BAR; }
    }
    PG8_WAIT_V(0);
    if constexpr (!ALIGN_EPI) { if (wr == 0) PG8_BAR; }
    PG8_BAR;
#undef PG8_SA
#undef PG8_SB
#undef PG8_STAGE
#undef PG8_LDA
#undef PG8_LDB
#undef PG8_MMA
#undef PG8_WAIT_V
#undef PG8_WAIT_L
#undef PG8_BAR
#undef PG8_SCHED
}
}
constexpr int NWAVES = 8, NTHREADS = 512;
constexpr int MP = 8192, MS = 256, MROWS = MP + MS;
constexpr int DM = 2048, INW = 6400, DFF = 5632, AW = 1024, RW = 1024, ZW = 3328, QKVW = 3072;
constexpr int NCH_P = 2048, NCH_S = 256, NCH = NCH_P + NCH_S;
constexpr int KSROWS = 544;
constexpr float RMS_EPS = 1e-6f, GN_EPS = 64e-5f;
constexpr float LOG2E = 1.4426950408889634f;
constexpr float QSCALE = 0.125f * LOG2E;

constexpr size_t OFF_Y = 0, OFF_YS = 16777216, OFF_KP = 17301504, OFF_VP = 17825792, OFF_WKVP = 18350080, OFF_SHP = 18415616,
                 OFF_KS = 18418944, OFF_VS = 18681088, OFF_WKVS = 18943232, OFF_SHS = 19991808, OUT_TOTAL = 20045056;

constexpr size_t al256(size_t x) { return (x + 255) & ~(size_t)255; }
constexpr size_t WS_CTL = 0, CTL_BYTES = 1u << 20;
constexpr size_t WS_W1T = CTL_BYTES;
constexpr size_t WS_W2T = WS_W1T + (size_t)INW * DM * 2;
constexpr size_t WS_LORA = WS_W2T + (size_t)DM * DM * 2;
constexpr size_t WS_A1 = WS_LORA + 524288;
constexpr size_t WS_QKV = WS_A1 + (size_t)MROWS * DM * 2;
constexpr size_t WS_Z = WS_QKV + (size_t)MROWS * QKVW * 2;
constexpr size_t WS_KS = WS_Z + (size_t)MROWS * ZW * 2;
constexpr size_t WS_VST = WS_KS + (size_t)16 * KSROWS * 1024 * 2;
constexpr size_t WS_RW = WS_VST + (size_t)16 * KSROWS * 1024 * 2;
constexpr size_t RW_PM = 0, RW_Y0 = RW_PM + (size_t)NCH * 8192, RW_GG = RW_Y0 + (size_t)NCH * 8192, RW_BN = RW_GG + (size_t)NCH * 8192,
                 RW_S0 = RW_BN + (size_t)NCH * 8192, RW_GC = RW_S0 + (size_t)NCH * 8192, RW_END = RW_GC + (size_t)NCH * 256;
constexpr size_t FF_BYTES = (size_t)MROWS * DFF * 2;
constexpr size_t RW_BYTES = (RW_END > FF_BYTES ? RW_END : FF_BYTES);
constexpr size_t WS_END = al256(WS_RW + RW_BYTES);
constexpr size_t WS_VT = WS_W1T;
constexpr size_t WS_HB = WS_KS;
constexpr size_t WS_W3T = WS_QKV;
constexpr size_t WS_W4T = WS_W3T + (size_t)2 * DFF * DM * 2;
constexpr size_t WS_FF = WS_RW;
static_assert((size_t)16 * KSROWS * 1024 * 2 * 2 >= (size_t)MROWS * DM * 2, "hb fits KS|VST");
static_assert(WS_W4T + (size_t)DM * DFF * 2 <= WS_KS, "W3T|W4T fit QKV|Z");
static_assert((size_t)1024 * 8192 * 2 <= (size_t)INW * DM * 2, "VT fits W1T");
constexpr size_t DO_GM = 0, DO_QP = (size_t)NCH * 16384;
static_assert(DO_QP + (size_t)NCH * 8192 <= (size_t)(OFF_KP) * 4, "GM|QP fit in the y region of d_out");

constexpr int CW_TMO = 0;
constexpr int CW_BAR = 4096;
constexpr int CW_QATT = 8192, CW_QCONV = 8256, CW_QS4 = 8320;
constexpr int CW_SSQ2 = 16384;
constexpr int CW_SSQ3 = 32768;
static_assert((CW_SSQ3 + MROWS) * 4 <= (int)CTL_BYTES, "ctl");

constexpr int RING_BYTES = 155648;
constexpr int LDSCTL_OFF = RING_BYTES, MISC_OFF = LDSCTL_OFF + 320;
constexpr int LDS_BYTES = 163840;

#define GAS __attribute__((address_space(1)))
#define LAS __attribute__((address_space(3)))
typedef unsigned short bf16;
typedef unsigned v4u __attribute__((ext_vector_type(4)));
typedef unsigned v2u __attribute__((ext_vector_type(2)));
typedef float f32x4 __attribute__((ext_vector_type(4)));
typedef float f32x2 __attribute__((ext_vector_type(2)));
typedef float f32x16 __attribute__((ext_vector_type(16)));
typedef short bf16x8 __attribute__((ext_vector_type(8)));
typedef short bf16x4 __attribute__((ext_vector_type(4)));
typedef GAS unsigned gu32;
#define RLX_AGENT __ATOMIC_RELAXED, __HIP_MEMORY_SCOPE_AGENT
#define LDS_WAIT() asm volatile("s_waitcnt lgkmcnt(0)" ::: "memory")
#define VM_WAIT() asm volatile("s_waitcnt vmcnt(0)" ::: "memory")
__device__ __forceinline__ unsigned f2bf(float f) { unsigned u = __builtin_bit_cast(unsigned, f); return (u + 0x7fffu + ((u >> 16) & 1u)) >> 16; }
__device__ __forceinline__ unsigned pk2(float lo, float hi) { return f2bf(lo) | (f2bf(hi) << 16); }
__device__ __forceinline__ float bf2f(unsigned short b) { return __builtin_bit_cast(float, (unsigned)b << 16); }
__device__ __forceinline__ float bflo(unsigned w) { return __builtin_bit_cast(float, w << 16); }
__device__ __forceinline__ float bfhi(unsigned w) { return __builtin_bit_cast(float, w & 0xffff0000u); }
__device__ __forceinline__ float wave_sum(float v) {
#pragma unroll
    for (int o = 1; o < 64; o <<= 1) v += __shfl_xor(v, o);
    return v;
}
__device__ __forceinline__ float fexp2(float x) { return __builtin_amdgcn_exp2f(x); }
__device__ __forceinline__ float fexp(float x) { return __builtin_amdgcn_exp2f(x * LOG2E); }
__device__ __forceinline__ float frcp(float x) { return __builtin_amdgcn_rcpf(x); }
__device__ __forceinline__ float fsigmoid(float x) { return frcp(1.f + fexp(-x)); }
__device__ __forceinline__ f32x16 mfma32(bf16x8 a, bf16x8 b, f32x16 c) { return __builtin_amdgcn_mfma_f32_32x32x16_bf16(a, b, c, 0, 0, 0); }
__device__ __forceinline__ f32x4 mfma16(bf16x8 a, bf16x8 b, f32x4 c) { return __builtin_amdgcn_mfma_f32_16x16x32_bf16(a, b, c, 0, 0, 0); }

#define XB_TMO      128
#define XB_XCNT(j)  (256  + 64 * (j))
#define XB_XSUB(j)  (1280 + 64 * (j))
#define XB_XGEN(j)  (2304 + 64 * (j))
#define XB_TOP      3328
#define XB_TOPGEN   3392
#define XCD_BAR_WORDS 3456
#define XB_SPIN_CAP (1u << 22)
__device__ __forceinline__ unsigned xb_ld(unsigned* p)              { return __hip_atomic_load(p, __ATOMIC_RELAXED, __HIP_MEMORY_SCOPE_AGENT); }
__device__ __forceinline__ unsigned xb_add(unsigned* p, unsigned v) { return __hip_atomic_fetch_add(p, v, __ATOMIC_RELAXED, __HIP_MEMORY_SCOPE_AGENT); }
__device__ __forceinline__ unsigned xb_xcc_id() { return (unsigned)__builtin_amdgcn_s_getreg((3 << 11) | 20) & 0xFu; }
#define XB_SPIN(cond, bar) do { unsigned _sp = 0; while (cond) { __builtin_amdgcn_s_sleep(1); \
    if ((++_sp & 255u) == 0u) { if (xb_ld(&(bar)[XB_TMO])) break; if (_sp > XB_SPIN_CAP) { atomicAdd(&(bar)[XB_TMO], 1u); break; } } } } while (0)
struct XcdBarrier { unsigned* bar; unsigned x; volatile LAS unsigned* st; };
__device__ __forceinline__ XcdBarrier xcd_barrier_post(unsigned* bar, volatile LAS unsigned* st) {
    XcdBarrier b; b.bar = bar; b.x = xb_xcc_id(); b.st = st;
    if (threadIdx.x == 0) (void)xb_add(&bar[XB_XCNT(b.x)], 1u);
    return b;
}
__device__ __forceinline__ void xcd_barrier_complete(unsigned* bar, unsigned x, unsigned& nloc, unsigned& nx) {
    const unsigned G = gridDim.x * gridDim.y * gridDim.z;
    unsigned sum, cnt, mine, sp = 0u;
    for (;;) {
        sum = 0u; cnt = 0u; mine = 0u;
#pragma unroll
        for (unsigned j = 0; j < 16; ++j) { const unsigned c = xb_ld(&bar[XB_XCNT(j)]); sum += c; cnt += (c > 0u) ? 1u : 0u; mine = (j == x) ? c : mine; }
        if (sum == G) break;
        __builtin_amdgcn_s_sleep(1);
        if ((++sp & 255u) == 0u) { if (xb_ld(&bar[XB_TMO])) break; if (sp > XB_SPIN_CAP) { atomicAdd(&bar[XB_TMO], 1u); break; } }
    }
    nloc = mine > 0u ? mine : 1u; nx = cnt > 0u ? cnt : 1u;
}
__device__ __forceinline__ void xcd_barrier(const XcdBarrier& b) {
    asm volatile("s_waitcnt vmcnt(0)" ::: "memory");
    __syncthreads();
    if (threadIdx.x == 0) {
        unsigned* bar = b.bar;
        __builtin_amdgcn_s_waitcnt(0);
        unsigned nloc = b.st[0], nx = b.st[1];
        if (nloc == 0u) { xcd_barrier_complete(bar, b.x, nloc, nx); b.st[0] = nloc; b.st[1] = nx; }
        const unsigned old = xb_add(&bar[XB_XSUB(b.x)], 1u);
        const unsigned gen = old / nloc;
        if (old + 1u == (gen + 1u) * nloc) {
            __builtin_amdgcn_fence(__ATOMIC_RELEASE, "agent");
            asm volatile("s_waitcnt vmcnt(0)" ::: "memory");
            const unsigned og = xb_add(&bar[XB_TOP], 1u);
            const unsigned tg = og / nx;
            if (og + 1u == (tg + 1u) * nx) xb_add(&bar[XB_TOPGEN], 1u);
            else XB_SPIN(xb_ld(&bar[XB_TOPGEN]) == tg, bar);
            __builtin_amdgcn_fence(__ATOMIC_ACQUIRE, "agent");
            xb_add(&bar[XB_XGEN(b.x)], 1u);
            asm volatile("s_waitcnt vmcnt(0)" ::: "memory");
        } else {
            XB_SPIN(xb_ld(&bar[XB_XGEN(b.x)]) == gen, bar);
            __builtin_amdgcn_fence(__ATOMIC_ACQUIRE, "agent");
            asm volatile("s_waitcnt vmcnt(0)" ::: "memory");
        }
    }
    __syncthreads();
}

struct Args {
    const float* in[26];
    float* out; unsigned char* ws;
};
__device__ __forceinline__ v4u pack8(f32x4 a, f32x4 b) { v4u w; w.x = pk2(a[0], a[1]); w.y = pk2(a[2], a[3]); w.z = pk2(b[0], b[1]); w.w = pk2(b[2], b[3]); return w; }

struct EpiG1 {
    static constexpr bool PERM = true;
    bf16* QKV; bf16* Z; float* out;
    __device__ __forceinline__ void operator()(const f32x4 (&acc)[2][2][4][2], const pg8::Unit& u, int wr, int wc, int fr, int fq) const {
        const int pn = u.pn, pm = u.pm;
        const int rowb = pm * 256 + wr * 64 + fr, cb = wc * 32 + 8 * fq;
#pragma unroll
        for (int ai = 0; ai < 2; ++ai)
#pragma unroll
            for (int m = 0; m < 4; ++m) {
                const int row = rowb + ai * 128 + m * 16;
#pragma unroll
                for (int bj = 0; bj < 2; ++bj) {
                    const int c = pn * 256 + bj * 128 + cb;
                    f32x4 v0 = acc[ai][bj][m][0], v1 = acc[ai][bj][m][1];
                    if (pn < 12) {
                        if (pn >= 4) {
                            const bool isk = pn < 8; const int cc = c - (isk ? 1024 : 2048);
                            float* dst = nullptr;
                            if (pm == 30 || pm == 31) dst = out + (isk ? OFF_KP : OFF_VP) + (size_t)(row - 7680) * 1024 + cc;
                            else if (pm == 32) dst = out + (isk ? OFF_KS : OFF_VS) + (size_t)(row - 8192) * 1024 + cc;
                            if (dst) { *(f32x4*)dst = v0; *(f32x4*)(dst + 4) = v1; }
                        } else { v0 = v0 * QSCALE; v1 = v1 * QSCALE; }
                        *(v4u*)(QKV + (size_t)row * QKVW + c) = pack8(v0, v1);
                    } else {
                        const int cz = c - QKVW;
                        *(v4u*)(Z + (size_t)row * ZW + cz) = pack8(v0, v1);
                        float* dst = nullptr;
                        if (row == MP - 1) dst = out + OFF_SHP + cz;
                        else if (pm == 32 && fr == 15) dst = out + OFF_SHS + (size_t)((row - MP) >> 4) * ZW + cz;
                        if (dst) { *(f32x4*)dst = v0; *(f32x4*)(dst + 4) = v1; }
                    }
                }
            }
    }
};

struct EpiG2 {
    static constexpr bool PERM = true;
    const float* xp; const float* xs; float* h; bf16* hb; float* ssq;
    __device__ __forceinline__ void operator()(const f32x4 (&acc)[2][2][4][2], const pg8::Unit& u, int wr, int wc, int fr, int fq) const {
        const int rowb = u.pm * 256 + wr * 64 + fr, cb = u.pn * 256 + wc * 32 + 8 * fq;
#pragma unroll
        for (int ai = 0; ai < 2; ++ai)
#pragma unroll
            for (int m = 0; m < 4; ++m) {
                const int row = rowb + ai * 128 + m * 16;
                const float* xr = row < MP ? xp + (size_t)row * DM : xs + (size_t)(row - MP) * DM;
                float sq = 0.f;
#pragma unroll
                for (int bj = 0; bj < 2; ++bj) {
                    const int c = cb + bj * 128;
                    const f32x4 v0 = acc[ai][bj][m][0] + *(const f32x4*)(xr + c), v1 = acc[ai][bj][m][1] + *(const f32x4*)(xr + c + 4);
                    float* hp = h + (size_t)row * DM + c; *(f32x4*)hp = v0; *(f32x4*)(hp + 4) = v1;
                    *(v4u*)(hb + (size_t)row * DM + c) = pack8(v0, v1);
                    sq += (v0[0] * v0[0] + v0[1] * v0[1]) + (v0[2] * v0[2] + v0[3] * v0[3]) + (v1[0] * v1[0] + v1[1] * v1[1]) + (v1[2] * v1[2] + v1[3] * v1[3]);
                }
                sq += __shfl_xor(sq, 16); sq += __shfl_xor(sq, 32);
                if (fq == 0) atomicAdd(ssq + row, sq);
            }
    }
};

struct EpiG3 {
    static constexpr bool PERM = true;
    const float* ssq; bf16* ff;
    __device__ __forceinline__ void operator()(const f32x4 (&acc)[2][2][4][2], const pg8::Unit& u, int wr, int wc, int fr, int fq) const {
        const int rowb = u.pm * 256 + wr * 64 + fr, cb = u.pn * 128 + wc * 32 + 8 * fq;
#pragma unroll
        for (int ai = 0; ai < 2; ++ai)
#pragma unroll
            for (int m = 0; m < 4; ++m) {
                const int row = rowb + ai * 128 + m * 16;
                const float rs = __builtin_amdgcn_rsqf(ssq[row] * (1.f / DM) + RMS_EPS);
                f32x4 o[2];
#pragma unroll
                for (int n = 0; n < 2; ++n)
#pragma unroll
                    for (int e = 0; e < 4; ++e) { const float g = acc[ai][0][m][n][e] * rs, up = acc[ai][1][m][n][e] * rs; o[n][e] = g * frcp(1.f + fexp(-g)) * up; }
                *(v4u*)(ff + (size_t)row * DFF + cb) = pack8(o[0], o[1]);
            }
    }
};

constexpr int G4_NSL = 11, G4_NK = 8;
struct SchedG4 {
    pg8::StaticOrder so; int G, c;
    __device__ void init(int G_, int c_) { so.init(MP, DM, DFF, G_, c_); G = G_; c = c_; }
    __device__ bool next(int i, pg8::Unit& u) const {
        const long L = (long)i * G + c; const int nfull = (MP / 256) * (DM / 256);
        if (L < nfull) return so.next(i, u);
        const int s = (int)(L - nfull); if (s >= 8 * G4_NSL) return false;
        u.pm = MP / 256; u.pn = s & 7; u.k0 = (s >> 3) * G4_NK; u.nk = G4_NK; return true;
    }
};
struct EpiG4 {
    static constexpr bool PERM = true;
    float* h; float* slab;
    __device__ __forceinline__ void operator()(const f32x4 (&acc)[2][2][4][2], const pg8::Unit& u, int wr, int wc, int fr, int fq) const {
        const int rowb = u.pm * 256 + wr * 64 + fr, cb = u.pn * 256 + wc * 32 + 8 * fq;
#pragma unroll
        for (int ai = 0; ai < 2; ++ai)
#pragma unroll
            for (int m = 0; m < 4; ++m) {
                const int row = rowb + ai * 128 + m * 16;
#pragma unroll
                for (int bj = 0; bj < 2; ++bj) {
                    if (u.pm < MP / 256) {
                        float* hp = h + (size_t)row * DM + cb + bj * 128;
                        const f32x4 v0 = acc[ai][bj][m][0] + *(const f32x4*)hp, v1 = acc[ai][bj][m][1] + *(const f32x4*)(hp + 4);
                        *(f32x4*)hp = v0; *(f32x4*)(hp + 4) = v1;
                    } else {
                        float* sp = slab + ((size_t)(u.k0 / G4_NK) * MS + (row - MP)) * DM + cb + bj * 128;
                        *(f32x4*)sp = acc[ai][bj][m][0]; *(f32x4*)(sp + 4) = acc[ai][bj][m][1];
                    }
                }
            }
    }
};
__device__ __forceinline__ void tr_item(const float* W, int ldw, bf16* WT, size_t ldo, int k0, int n0, int orow0, const float* kscale, LAS float* scr, int lane) {
    f32x4 v[8];
    const float* src = W + (size_t)(k0 + (lane >> 3)) * ldw + n0 + 4 * (lane & 7);
#pragma unroll
    for (int i = 0; i < 8; ++i) v[i] = *(const f32x4*)(src + (size_t)(8 * i) * ldw);
#pragma unroll
    for (int i = 0; i < 8; ++i) { const int kk = 8 * i + (lane >> 3); f32x4 x = v[i]; if (kscale) x = x * kscale[k0 + kk];
        LAS float* d = scr + kk * 33 + 4 * (lane & 7); d[0] = x[0]; d[1] = x[1]; d[2] = x[2]; d[3] = x[3]; }
    LDS_WAIT(); asm volatile("" ::: "memory");
    const int c = lane & 7;
#pragma unroll
    for (int j = 0; j < 4; ++j) { const int n = (lane >> 3) + 8 * j; const LAS float* s = scr + (8 * c) * 33 + n;
        v4u o; o.x = pk2(s[0 * 33], s[1 * 33]); o.y = pk2(s[2 * 33], s[3 * 33]); o.z = pk2(s[4 * 33], s[5 * 33]); o.w = pk2(s[6 * 33], s[7 * 33]);
        *(v4u*)(WT + (size_t)(orow0 + n) * ldo + k0 + 8 * c) = o; }
    LDS_WAIT(); asm volatile("" ::: "memory");
}
__device__ __forceinline__ void rms_row(const float* xrow, const float* g, bf16* orow, int lane) {
    const f32x4* xr = (const f32x4*)xrow + lane; const f32x4* gr = (const f32x4*)g + lane;
    f32x4 v[8]; float s = 0.f;
#pragma unroll
    for (int j = 0; j < 8; ++j) { v[j] = xr[64 * j]; s += (v[j][0] * v[j][0] + v[j][1] * v[j][1]) + (v[j][2] * v[j][2] + v[j][3] * v[j][3]); }
    const float rstd = __builtin_amdgcn_rsqf(wave_sum(s) * (1.f / DM) + RMS_EPS);
    v2u* o8 = (v2u*)orow + lane;
#pragma unroll
    for (int j = 0; j < 8; ++j) { const f32x4 gg = gr[64 * j]; v2u w; w.x = pk2(v[j][0] * rstd * gg[0], v[j][1] * rstd * gg[1]); w.y = pk2(v[j][2] * rstd * gg[2], v[j][3] * rstd * gg[3]); o8[64 * j] = w; }
}
__device__ __forceinline__ void cvt_row1024(const float* src, bf16* dst, int lane) {
    const f32x4* s = (const f32x4*)src + lane; v2u* o = (v2u*)dst + lane;
#pragma unroll
    for (int j = 0; j < 4; ++j) { const f32x4 v = s[64 * j]; v2u w; w.x = pk2(v[0], v[1]); w.y = pk2(v[2], v[3]); o[64 * j] = w; }
}

struct P0Params { const float *xp, *xs, *ck, *cv, *ln1, *w_in, *w_w2, *a_w2, *g_w2, *w_o; bf16 *W1T, *W2T, *LWT, *LAT, *LGT, *A1, *KS, *VST; };
__device__ __forceinline__ void p0_prologue(const P0Params& P, LAS unsigned char* lds, int gw, int NGW, int wave, int lane) {
    LAS float* scr = (LAS float*)(lds + wave * 16384);
    constexpr int I_W1 = (DM / 64) * (INW / 32), I_W2 = (DM / 64) * (DM / 32), I_LW = 32, I_LA = 32, I_LG = 64, I_CV = 16 * 8 * 32;
    constexpr int NITEMS = I_W1 + I_W2 + I_LW + I_LA + I_LG + I_CV;
    for (int it = gw; it < NITEMS; it += NGW) {
        int r = it;
        if (r < I_W1) { const int nb = INW / 32; tr_item(P.w_in, INW, P.W1T, DM, 64 * (r / nb), 32 * (r % nb), 32 * (r % nb), nullptr, scr, lane); continue; } r -= I_W1;
        if (r < I_W2) { const int nb = DM / 32; tr_item(P.w_o, DM, P.W2T, DM, 64 * (r / nb), 32 * (r % nb), 32 * (r % nb), nullptr, scr, lane); continue; } r -= I_W2;
        if (r < I_LW) { tr_item(P.w_w2, RW, P.LWT, 64, 0, 32 * r, 32 * r, nullptr, scr, lane); continue; } r -= I_LW;
        if (r < I_LA) { tr_item(P.a_w2, RW, P.LAT, 64, 0, 32 * r, 32 * r, nullptr, scr, lane); continue; } r -= I_LA;
        if (r < I_LG) { tr_item(P.g_w2, RW, P.LGT, 128, 64 * (r / 32), 32 * (r % 32), 32 * (r % 32), nullptr, scr, lane); continue; } r -= I_LG;
        { const int b = r / 256, q = r % 256, kb = q / 32, nb = q % 32;
          tr_item(P.cv + (size_t)b * 512 * 1024, 1024, P.VST + (size_t)b * 1024 * KSROWS, KSROWS, 64 * kb, 32 * nb, 32 * nb, nullptr, scr, lane); }
    }
    for (int m = gw; m < MROWS; m += NGW) rms_row(m < MP ? P.xp + (size_t)m * DM : P.xs + (size_t)(m - MP) * DM, P.ln1, P.A1 + (size_t)m * DM, lane);
    for (int m = gw; m < 16 * 512; m += NGW) { const int b = m >> 9, t = m & 511; cvt_row1024(P.ck + (size_t)m * 1024, P.KS + ((size_t)b * KSROWS + t) * 1024, lane); }
}

__device__ __forceinline__ void final_norm_row(float* row, const float* g, const float* slab, int lane) {
    f32x4* xr = (f32x4*)row + lane; const f32x4* gr = (const f32x4*)g + lane;
    f32x4 v[8]; float s = 0.f;
#pragma unroll
    for (int j = 0; j < 8; ++j) v[j] = xr[64 * j];
    if (slab) {
        for (int sl = 0; sl < G4_NSL; ++sl) { const f32x4* sp = (const f32x4*)(slab + (size_t)sl * MS * DM) + lane;
#pragma unroll
            for (int j = 0; j < 8; ++j) v[j] = v[j] + sp[64 * j]; }
    }
#pragma unroll
    for (int j = 0; j < 8; ++j) s += (v[j][0] * v[j][0] + v[j][1] * v[j][1]) + (v[j][2] * v[j][2] + v[j][3] * v[j][3]);
    const float rs = __builtin_amdgcn_rsqf(wave_sum(s) * (1.f / DM) + RMS_EPS);
#pragma unroll
    for (int j = 0; j < 8; ++j) { const f32x4 gg = gr[64 * j]; f32x4 o = v[j] * rs; o = o * gg; xr[64 * j] = o; }
}
constexpr int PB = 144;
constexpr int L_LFW = 0, L_LFA = 9216, L_LFG = 18432;
constexpr int L_LP = 0, L_AAK = 16384;
constexpr int L_ACT = 27648, ACT_PITCH = 528;
constexpr int L_AQB = 27648, L_AQK = 36864, L_RHS2 = 46080;
constexpr int L_AM = 62464, L_RM = 71680, L_BM = 80896, L_KM = 90112;
constexpr int L_XT = 80896;
constexpr int L_BHT = 99328, L_KHT = 108544, L_VTT = 117760;
constexpr int L_CUMT = 126976;
static_assert(L_CUMT + 2048 <= RING_BYTES, "rwkv lds");

#define BLK_SYNC() do { asm volatile("s_waitcnt vmcnt(0) lgkmcnt(0)" ::: "memory"); __builtin_amdgcn_s_barrier(); asm volatile("" ::: "memory"); } while (0)
#define LDS_SYNC() do { asm volatile("s_waitcnt lgkmcnt(0)" ::: "memory"); __builtin_amdgcn_s_barrier(); asm volatile("" ::: "memory"); } while (0)

__device__ __forceinline__ f32x16 mm_tile(LAS const unsigned char* A, LAS const unsigned char* B, int mt, int nt, int lane, f32x16 acc) {
    const int row = lane & 31, h = lane >> 5;
    LAS const unsigned char* pa = A + (32 * mt + row) * PB + h * 16;
    LAS const unsigned char* pb = B + (32 * nt + row) * PB + h * 16;
#pragma unroll
    for (int s = 0; s < 4; ++s) { const bf16x8 a = *(LAS const bf16x8*)(pa + s * 32); const bf16x8 b = *(LAS const bf16x8*)(pb + s * 32); acc = mfma32(a, b, acc); }
    return acc;
}
#define CROW(r, h) (((r) & 3) + 8 * ((r) >> 2) + 4 * (h))

struct RwkvParams {
    const bf16* Z; const float* shift_in; const float *mu, *w0, *a0, *k_k, *k_a, *r_k;
    const bf16 *LWT, *LAT, *LGT;
    bf16 *PM, *Y0, *GG, *BN, *QP; float *GM, *GC;
};

__device__ __forceinline__ void rwkv_chunk(const RwkvParams& P, int ch, LAS unsigned char* lds, int tid, int wave, int lane) {
    const bool samp = ch >= NCH_P; const int hd = ch & 15; const int cb = samp ? (ch - NCH_P) >> 4 : ch >> 4;
    const int row0 = samp ? MP + 16 * cb : 64 * cb; const int nvalid = samp ? 16 : 64;
    const float* shp = samp ? P.shift_in + (size_t)cb * ZW : nullptr;
    const bool prev_zero = (!samp && cb == 0);
    {
        const int col = tid & 255, th = tid >> 8, zc = 3072 + col;
        const float muc = P.mu[zc];
        float prev;
        if (th == 0) prev = prev_zero ? 0.f : (samp ? shp[zc] : bf2f(P.Z[(size_t)(row0 - 1) * ZW + zc]));
        else prev = (31 < nvalid) ? bf2f(P.Z[(size_t)(row0 + 31) * ZW + zc]) : 0.f;
#pragma unroll 4
        for (int i = 0; i < 32; ++i) {
            const int t = 32 * th + i; float a = 0.f;
            if (t < nvalid) {
                const float z = bf2f(P.Z[(size_t)(row0 + t) * ZW + zc]);
                const float zs = z + (prev - z) * muc; prev = z;
                if (col < 64) { const float e = fexp(2.f * zs); a = 1.f - 2.f * frcp(e + 1.f); }
                else if (col < 128) a = zs;
                else a = fsigmoid(zs);
            }
            *(LAS bf16*)(lds + L_ACT + t * ACT_PITCH + col * 2) = (bf16)f2bf(a);
        }
    }
    LDS_SYNC();
    {
        const int w4 = wave & 3, mt = w4 >> 1, nt = w4 & 1, row = lane & 31, h = lane >> 5;
        LAS const unsigned char* pa = lds + L_ACT + (32 * mt + row) * ACT_PITCH + h * 16;
        const int jg = 64 * hd + 32 * nt + row;
        if (wave < 4) {
            f32x16 aw = {}, aa = {};
            const bf16* bw = P.LWT + (size_t)jg * 64 + h * 8; const bf16* ba = P.LAT + (size_t)jg * 64 + h * 8;
#pragma unroll
            for (int s = 0; s < 4; ++s) {
                aw = mfma32(*(LAS const bf16x8*)(pa + s * 32), *(const bf16x8*)(bw + s * 16), aw);
                aa = mfma32(*(LAS const bf16x8*)(pa + 128 + s * 32), *(const bf16x8*)(ba + s * 16), aa);
            }
#pragma unroll
            for (int r = 0; r < 16; ++r) { const int t = 32 * mt + CROW(r, h), j = 32 * nt + row;
                *(LAS bf16*)(lds + L_LFW + t * PB + j * 2) = (bf16)f2bf(aw[r]); *(LAS bf16*)(lds + L_LFA + t * PB + j * 2) = (bf16)f2bf(aa[r]); }
        } else {
            f32x16 ag = {};
            const bf16* bg = P.LGT + (size_t)jg * 128 + h * 8;
#pragma unroll
            for (int s = 0; s < 8; ++s) ag = mfma32(*(LAS const bf16x8*)(pa + 256 + s * 32), *(const bf16x8*)(bg + s * 16), ag);
#pragma unroll
            for (int r = 0; r < 16; ++r) { const int t = 32 * mt + CROW(r, h), j = 32 * nt + row; *(LAS bf16*)(lds + L_LFG + t * PB + j * 2) = (bf16)f2bf(ag[r]); }
        }
    }
    LDS_SYNC();
    {
        const int j = lane, tg = wave, jh = 64 * hd + j, t0 = 8 * tg;
        const float mur = P.mu[jh], muk = P.mu[1024 + jh], muv = P.mu[2048 + jh];
        const float w0v = P.w0[jh], a0v = P.a0[jh], kkw = P.k_k[jh], kaw = P.k_a[jh], rkw = P.r_k[jh];
        float pr = 0.f, pk = 0.f, pv = 0.f;
        if (tg == 0) { if (!prev_zero) { if (samp) { pr = shp[jh]; pk = shp[1024 + jh]; pv = shp[2048 + jh]; }
                                          else { const bf16* zp = P.Z + (size_t)(row0 - 1) * ZW + jh; pr = bf2f(zp[0]); pk = bf2f(zp[1024]); pv = bf2f(zp[2048]); } } }
        else if (t0 - 1 < nvalid) { const bf16* zp = P.Z + (size_t)(row0 + t0 - 1) * ZW + jh; pr = bf2f(zp[0]); pk = bf2f(zp[1024]); pv = bf2f(zp[2048]); }
        float lw2[8], cl[8], rr[8], kp[8], vv[8], kk[8], al[8];
        bf16* ggp = P.GG + (size_t)ch * 4096 + j; bf16* bnp = P.BN + (size_t)ch * 4096 + j;
        float run = 0.f;
#pragma unroll
        for (int i = 0; i < 8; ++i) {
            const int t = t0 + i; const bool valid = t < nvalid;
            float zr = 0.f, zk = 0.f, zv = 0.f;
            if (valid) { const bf16* zp = P.Z + (size_t)(row0 + t) * ZW + jh; zr = bf2f(zp[0]); zk = bf2f(zp[1024]); zv = bf2f(zp[2048]); }
            const float r = zr + (pr - zr) * mur, k = zk + (pk - zk) * muk, v = zv + (pv - zv) * muv; pr = zr; pk = zk; pv = zv;
            const float dW = bf2f(*(LAS const bf16*)(lds + L_LFW + t * PB + j * 2)), dA = bf2f(*(LAS const bf16*)(lds + L_LFA + t * PB + j * 2)), g = bf2f(*(LAS const bf16*)(lds + L_LFG + t * PB + j * 2));
            const float x = -(w0v + dW);
            const float sp = fmaxf(x, 0.f) + __logf(1.f + fexp(-fabsf(x)));
            const float lw = -fexp(-sp - 0.5f);
            const float alpha = fsigmoid(a0v + dA);
            const float kkr = k * kkw; const float n2 = wave_sum(kkr * kkr);
            const float kkn = kkr * frcp(fmaxf(sqrtf(n2), 1e-12f));
            const float kmod = k * (1.f + (alpha - 1.f) * kaw);
            const float bs = wave_sum(r * kmod * rkw);
            lw2[i] = valid ? lw * LOG2E : 0.f; rr[i] = valid ? r : 0.f; kp[i] = valid ? kmod : 0.f; vv[i] = valid ? v : 0.f; kk[i] = valid ? kkn : 0.f; al[i] = alpha;
            run += lw2[i]; cl[i] = run;
            ggp[t * 64] = (bf16)f2bf(g); bnp[t * 64] = (bf16)f2bf(valid ? bs * v : 0.f);
        }
        LAS float* cum = (LAS float*)(lds + L_CUMT);
        cum[tg * 64 + j] = run;
        LDS_SYNC();
        float off = 0.f, tot = 0.f;
#pragma unroll
        for (int g8 = 0; g8 < 8; ++g8) { const float c = cum[g8 * 64 + j]; tot += c; off += (g8 < tg) ? c : 0.f; }
        float bh[8], kh[8];
#pragma unroll
        for (int i = 0; i < 8; ++i) {
            const int t = t0 + i; const float cu = off + cl[i];
            const float gin = fexp2(cu), gex = fexp2(cu - lw2[i]), ginv = fexp2(-cu), gend = fexp2(tot - cu);
            const float b = kk[i] * al[i];
            *(LAS bf16*)(lds + L_AM + t * PB + j * 2) = (bf16)f2bf(-gex * kk[i]);
            *(LAS bf16*)(lds + L_RM + t * PB + j * 2) = (bf16)f2bf(gin * rr[i]);
            *(LAS bf16*)(lds + L_BM + t * PB + j * 2) = (bf16)f2bf(b * ginv);
            *(LAS bf16*)(lds + L_KM + t * PB + j * 2) = (bf16)f2bf(kp[i] * ginv);
            bh[i] = b * gend; kh[i] = kp[i] * gend;
        }
        v4u w;
        w.x = pk2(bh[0], bh[1]); w.y = pk2(bh[2], bh[3]); w.z = pk2(bh[4], bh[5]); w.w = pk2(bh[6], bh[7]); *(LAS v4u*)(lds + L_BHT + j * PB + tg * 16) = w;
        w.x = pk2(kh[0], kh[1]); w.y = pk2(kh[2], kh[3]); w.z = pk2(kh[4], kh[5]); w.w = pk2(kh[6], kh[7]); *(LAS v4u*)(lds + L_KHT + j * PB + tg * 16) = w;
        w.x = pk2(vv[0], vv[1]); w.y = pk2(vv[2], vv[3]); w.z = pk2(vv[4], vv[5]); w.w = pk2(vv[6], vv[7]); *(LAS v4u*)(lds + L_VTT + j * PB + tg * 16) = w;
        if (tg == 0) P.GC[(size_t)ch * 64 + j] = fexp2(tot);
    }
    LDS_SYNC();
    {
        const int h = lane >> 5, col = lane & 31;
        for (int T = wave; T < 12; T += 8) {
            const int mat = T / 3, tile = T % 3, tt = tile > 0 ? 1 : 0, st = tile > 1 ? 1 : 0;
            LAS const unsigned char* A = lds + ((mat < 2) ? L_AM : L_RM);
            LAS const unsigned char* B = lds + ((mat & 1) ? L_KM : L_BM);
            f32x16 acc = {}; acc = mm_tile(A, B, tt, st, lane, acc);
            const int s = 32 * st + col;
#pragma unroll
            for (int r = 0; r < 16; ++r) {
                const int t = 32 * tt + CROW(r, h);
                if (mat == 0) { ((LAS float*)(lds + L_LP))[t * 64 + (s & 1) * 32 + (s >> 1)] = (s < t) ? acc[r] : 0.f; }
                else {
                    const bool keep = (mat == 1) ? (s < t) : (s <= t);
                    const int base = (mat == 1) ? L_AAK : ((mat == 2) ? L_AQB : L_AQK);
                    *(LAS bf16*)(lds + base + t * PB + s * 2) = (bf16)f2bf(keep ? acc[r] : 0.f);
                }
            }
        }
        if (wave >= 4 && wave < 7) {
            const int base = (wave == 4) ? L_AAK : ((wave == 5) ? L_AQB : L_AQK);
            const v4u z = {0u, 0u, 0u, 0u};
            LAS v4u* p = (LAS v4u*)(lds + base + col * PB + 64 + h * 32); p[0] = z; p[1] = z;
        }
    }
    LDS_SYNC();
    if (wave < 4) {
        const int tt = wave >> 1, vt = wave & 1, h = lane >> 5, col = lane & 31;
        f32x16 acc = {}; acc = mm_tile(lds + L_AAK, lds + L_VTT, tt, vt, lane, acc);
#pragma unroll
        for (int r = 0; r < 16; ++r) ((LAS float*)(lds + L_RHS2))[(32 * tt + CROW(r, h)) * 64 + 32 * vt + col] = acc[r];
    }
    LDS_SYNC();
    if (wave < 4) {
        const int c = 32 * wave + (lane & 31), par = lane >> 5;
        LAS const float* Lp = (LAS const float*)(lds + L_LP) + par * 32;
        float x[32];
#pragma unroll
        for (int i = 0; i < 32; ++i) x[i] = 0.f;
#pragma unroll
        for (int t = 0; t < 64; ++t) {
            float rhs;
            if (wave < 2) rhs = bf2f(*(LAS const bf16*)(lds + L_AM + t * PB + c * 2)); else rhs = ((LAS const float*)(lds + L_RHS2))[t * 64 + (c - 64)];
            float p0 = 0.f, p1 = 0.f;
            constexpr int dummy = 0; (void)dummy;
            const int nq = ((t + 1) / 2 + 3) / 4;
#pragma unroll
            for (int q = 0; q < 8; ++q) if (q < nq) {
                const f32x4 l4 = *(LAS const f32x4*)(Lp + t * 64 + 4 * q);
                p0 += l4[0] * x[4 * q]; p1 += l4[1] * x[4 * q + 1]; p0 += l4[2] * x[4 * q + 2]; p1 += l4[3] * x[4 * q + 3];
            }
            const float p = p0 + p1;
            const float xt = rhs + p + __shfl_xor(p, 32);
            if ((t & 1) == par) { x[t >> 1] = xt; *(LAS bf16*)(lds + L_XT + c * PB + t * 2) = (bf16)f2bf(xt); }
        }
    }
    LDS_SYNC();
    {
        const int w4 = wave & 3, mt = w4 >> 1, nt = w4 & 1, h = lane >> 5, col = lane & 31;
        if (wave < 4) {
            f32x16 acc = {}; acc = mm_tile(lds + L_AQB, lds + L_XT, mt, nt, lane, acc);
            bf16* qp = P.QP + (size_t)ch * 4096;
#pragma unroll
            for (int r = 0; r < 16; ++r) { const int t = 32 * mt + CROW(r, h), j = 32 * nt + col;
                qp[t * 64 + j] = (bf16)f2bf(acc[r] + bf2f(*(LAS const bf16*)(lds + L_RM + t * PB + j * 2))); }
            f32x16 pm = {}; pm = mm_tile(lds + L_BHT, lds + L_XT, mt, nt, lane, pm);
            bf16* pmp = P.PM + (size_t)ch * 4096;
#pragma unroll
            for (int r = 0; r < 16; ++r) { const int i = 32 * mt + CROW(r, h), j = 32 * nt + col;
                const int i4 = i >> 4, m = i & 15, ks = j >> 5, e = ((j >> 4) & 1) * 4 + (j & 3), q = (j >> 2) & 3;
                pmp[((i4 * 2 + ks) * 64 + q * 16 + m) * 8 + e] = (bf16)f2bf(pm[r]); }
        } else {
            f32x16 acc = {}; acc = mm_tile(lds + L_AQB, lds + L_XT + 64 * PB, mt, nt, lane, acc); acc = mm_tile(lds + L_AQK, lds + L_VTT, mt, nt, lane, acc);
            bf16* y0 = P.Y0 + (size_t)ch * 4096;
#pragma unroll
            for (int r = 0; r < 16; ++r) { const int t = 32 * mt + CROW(r, h), v = 32 * nt + col; y0[t * 64 + v] = (bf16)f2bf(acc[r]); }
            f32x16 gm = {}; gm = mm_tile(lds + L_BHT, lds + L_XT + 64 * PB, mt, nt, lane, gm); gm = mm_tile(lds + L_KHT, lds + L_VTT, mt, nt, lane, gm);
            float* gmp = P.GM + (size_t)ch * 4096;
#pragma unroll
            for (int r = 0; r < 16; ++r) { const int i = 32 * mt + CROW(r, h), v = 32 * nt + col;
                const int sl = v >> 4, n = v & 15, i4 = i >> 4, q = (i >> 2) & 3, reg = i & 3;
                gmp[((sl * 4 + i4) * 64 + q * 16 + n) * 4 + reg] = gm[r]; }
        }
    }
    LDS_SYNC();
}
__device__ __forceinline__ void vt_item(const bf16* QKV, bf16* VT, int item, LAS unsigned char* scr, int lane) {
    const int tb = item >> 4, hd = item & 15;
    const bf16* src = QKV + (size_t)(64 * tb) * QKVW + 2048 + 64 * hd;
#pragma unroll
    for (int i = 0; i < 8; ++i) {
        const int t = i * 8 + (lane >> 3), p = lane & 7;
        const v4u v = *(const v4u*)(src + (size_t)t * QKVW + 8 * p);
        const unsigned w[4] = {v.x, v.y, v.z, v.w};
#pragma unroll
        for (int e = 0; e < 8; ++e) *(LAS bf16*)(scr + (8 * p + e) * PB + t * 2) = (bf16)((w[e >> 1] >> ((e & 1) * 16)) & 0xffffu);
    }
    LDS_WAIT(); asm volatile("" ::: "memory");
#pragma unroll
    for (int i = 0; i < 8; ++i) {
        const int d = i * 8 + (lane >> 3), p = lane & 7;
        const v4u v = *(LAS const v4u*)(scr + d * PB + p * 16);
        *(v4u*)(VT + (size_t)(64 * hd + d) * MP + 64 * tb + 8 * p) = v;
    }
    LDS_WAIT(); asm volatile("" ::: "memory");
}
__device__ __forceinline__ void samp_kv_item(const bf16* QKV, bf16* KS, bf16* VST, int item, int lane) {
    const int b = item >> 4, cbk = item & 15, col = 64 * cbk + lane;
    unsigned short kv[16], vv[16];
#pragma unroll
    for (int s = 0; s < 16; ++s) { const bf16* rp = QKV + (size_t)(MP + 16 * b + s) * QKVW; kv[s] = rp[1024 + col]; vv[s] = rp[2048 + col]; }
    bf16* ks = KS + ((size_t)b * KSROWS + 512) * 1024 + col;
#pragma unroll
    for (int s = 0; s < 16; ++s) { ks[(size_t)s * 1024] = kv[s]; ks[(size_t)(16 + s) * 1024] = 0; }
    v4u w0, w1; const v4u z = {0u, 0u, 0u, 0u};
    w0.x = (unsigned)vv[0] | ((unsigned)vv[1] << 16); w0.y = (unsigned)vv[2] | ((unsigned)vv[3] << 16); w0.z = (unsigned)vv[4] | ((unsigned)vv[5] << 16); w0.w = (unsigned)vv[6] | ((unsigned)vv[7] << 16);
    w1.x = (unsigned)vv[8] | ((unsigned)vv[9] << 16); w1.y = (unsigned)vv[10] | ((unsigned)vv[11] << 16); w1.z = (unsigned)vv[12] | ((unsigned)vv[13] << 16); w1.w = (unsigned)vv[14] | ((unsigned)vv[15] << 16);
    v4u* vp = (v4u*)(VST + ((size_t)b * 1024 + col) * KSROWS + 512);
    vp[0] = w0; vp[1] = w1; vp[2] = z; vp[3] = z;
}

struct ScanParams { const bf16* PM; const float* GM; const float* GC; bf16* S0; const float* wkv_in; float* out; };
struct ScanFrag { bf16x8 pm[4][2]; f32x4 gm[4]; f32x4 gc[4]; };
__device__ __forceinline__ void scan_load(ScanFrag& F, const ScanParams& P, int ch, int sl, int lane) {
    const bf16* pm = P.PM + (size_t)ch * 4096 + lane * 8; const float* gm = P.GM + (size_t)ch * 4096 + (sl * 4 * 64 + lane) * 4; const float* gc = P.GC + (size_t)ch * 64 + 4 * (lane >> 4);
#pragma unroll
    for (int i4 = 0; i4 < 4; ++i4) { F.pm[i4][0] = *(const bf16x8*)(pm + (i4 * 2) * 512); F.pm[i4][1] = *(const bf16x8*)(pm + (i4 * 2 + 1) * 512);
        F.gm[i4] = *(const f32x4*)(gm + i4 * 256); F.gc[i4] = *(const f32x4*)(gc + 16 * i4); }
}
__device__ __forceinline__ void scan_task(const ScanParams& P, int seq, int sl, int lane) {
    const int n = lane & 15, q = lane >> 4, v = 16 * sl + n;
    const bool samp = seq >= 16; const int nsteps = samp ? 1 : 128;
    float* fin = samp ? P.out + OFF_WKVS + (size_t)(seq - 16) * 4096 : P.out + OFF_WKVP + (size_t)seq * 4096;
    f32x4 acc[4];
#pragma unroll
    for (int i4 = 0; i4 < 4; ++i4) acc[i4] = samp ? *(const f32x4*)(P.wkv_in + (size_t)(seq - 16) * 4096 + v * 64 + 16 * i4 + 4 * q) : (f32x4){0.f, 0.f, 0.f, 0.f};
    ScanFrag cur, nxt;
    int ch = samp ? NCH_P + (seq - 16) : seq;
    scan_load(cur, P, ch, sl, lane);
    for (int st = 0; st < nsteps; ++st) {
        const int chn = ch + 16;
        if (st + 1 < nsteps) scan_load(nxt, P, chn, sl, lane);
        v2u p[4];
#pragma unroll
        for (int i4 = 0; i4 < 4; ++i4) { p[i4].x = pk2(acc[i4][0], acc[i4][1]); p[i4].y = pk2(acc[i4][2], acc[i4][3]); }
        bf16* s0 = P.S0 + (size_t)ch * 4096 + v * 64 + 4 * q;
#pragma unroll
        for (int i4 = 0; i4 < 4; ++i4) *(v2u*)(s0 + 16 * i4) = p[i4];
        const v4u b0u = {p[0].x, p[0].y, p[1].x, p[1].y}, b1u = {p[2].x, p[2].y, p[3].x, p[3].y};
        const bf16x8 b0 = __builtin_bit_cast(bf16x8, b0u), b1 = __builtin_bit_cast(bf16x8, b1u);
#pragma unroll
        for (int i4 = 0; i4 < 4; ++i4) {
            f32x4 d = mfma16(cur.pm[i4][0], b0, cur.gm[i4]); d = mfma16(cur.pm[i4][1], b1, d);
            acc[i4] = cur.gc[i4] * acc[i4] + d;
        }
        if (st + 1 < nsteps) { cur = nxt; ch = chn; }
    }
#pragma unroll
    for (int i4 = 0; i4 < 4; ++i4) *(f32x4*)(fin + v * 64 + 16 * i4 + 4 * q) = acc[i4];
}

struct S4Params { const bf16 *S0, *QP, *Y0, *GG, *BN; const float *lnx_w, *lnx_b; bf16* mix; };
__device__ __forceinline__ void stage4_task(const S4Params& P, int item, int lane) {
    const int ch = item >> 1, tt = item & 1; const bool samp = ch >= NCH_P; const int hd = ch & 15;
    if (samp && tt == 1) return;
    const int cbi = samp ? (ch - NCH_P) >> 4 : ch >> 4; const int row0 = samp ? MP + 16 * cbi : 64 * cbi; const int nvalid = samp ? 16 : 64;
    const int l31 = lane & 31, h = lane >> 5, t = 32 * tt + l31;
    const bf16* s0 = P.S0 + (size_t)ch * 4096; const bf16* qp = P.QP + (size_t)ch * 4096 + t * 64 + 8 * h;
    f32x16 acc[2] = {};
#pragma unroll
    for (int s = 0; s < 4; ++s) {
        const bf16x8 b = *(const bf16x8*)(qp + 16 * s);
#pragma unroll
        for (int vt = 0; vt < 2; ++vt) acc[vt] = mfma32(*(const bf16x8*)(s0 + (32 * vt + l31) * 64 + 16 * s + 8 * h), b, acc[vt]);
    }
    const bf16* y0 = P.Y0 + (size_t)ch * 4096 + t * 64; const bf16* gg = P.GG + (size_t)ch * 4096 + t * 64; const bf16* bn = P.BN + (size_t)ch * 4096 + t * 64;
    float y[2][16]; float s1 = 0.f;
#pragma unroll
    for (int vt = 0; vt < 2; ++vt)
#pragma unroll
        for (int g = 0; g < 4; ++g) { const v2u w = *(const v2u*)(y0 + 32 * vt + 8 * g + 4 * h);
            y[vt][4 * g + 0] = acc[vt][4 * g + 0] + bflo(w.x); y[vt][4 * g + 1] = acc[vt][4 * g + 1] + bfhi(w.x); y[vt][4 * g + 2] = acc[vt][4 * g + 2] + bflo(w.y); y[vt][4 * g + 3] = acc[vt][4 * g + 3] + bfhi(w.y);
            s1 += (y[vt][4 * g] + y[vt][4 * g + 1]) + (y[vt][4 * g + 2] + y[vt][4 * g + 3]); }
    s1 += __shfl_xor(s1, 32);
    const float mean = s1 * (1.f / 64.f); float s2 = 0.f;
#pragma unroll
    for (int vt = 0; vt < 2; ++vt)
#pragma unroll
        for (int r = 0; r < 16; ++r) { const float d = y[vt][r] - mean; s2 += d * d; }
    s2 += __shfl_xor(s2, 32);
    const float rstd = __builtin_amdgcn_rsqf(s2 * (1.f / 64.f) + GN_EPS);
    if (l31 + 32 * tt < nvalid) {
        bf16* op = P.mix + (size_t)(row0 + t) * DM + 1024 + 64 * hd;
#pragma unroll
        for (int vt = 0; vt < 2; ++vt)
#pragma unroll
            for (int g = 0; g < 4; ++g) { const int v0 = 32 * vt + 8 * g + 4 * h;
                const f32x4 lw = *(const f32x4*)(P.lnx_w + 64 * hd + v0), lb = *(const f32x4*)(P.lnx_b + 64 * hd + v0);
                const v2u gw = *(const v2u*)(gg + v0), bw = *(const v2u*)(bn + v0);
                const float gv[4] = {bflo(gw.x), bfhi(gw.x), bflo(gw.y), bfhi(gw.y)}, bv[4] = {bflo(bw.x), bfhi(bw.x), bflo(bw.y), bfhi(bw.y)};
                float o[4];
#pragma unroll
                for (int e = 0; e < 4; ++e) o[e] = ((y[vt][4 * g + e] - mean) * rstd * lw[e] + lb[e] + bv[e]) * gv[e];
                v2u w; w.x = pk2(o[0], o[1]); w.y = pk2(o[2], o[3]); *(v2u*)(op + v0) = w; }
    }
}

struct AttnParams { const bf16 *QKV, *VT, *KS, *VST; bf16* mix; };
__device__ __forceinline__ int swap23(int r) { return (r & ~12) | ((r & 4) << 1) | ((r & 8) >> 1); }
__device__ __forceinline__ void attn_unit(const AttnParams& P, int unit, LAS const float* tbl, int lane) {
    const int q = lane & 31, h = lane >> 5;
    int hd, qrow0, nq, qpos0, kt0, kt1, nkeys; const bf16 *Kb, *Vb; size_t kpitch, vpitch;
    if (unit < 4096) { const int c = unit >> 5, qh = unit & 1; hd = (unit >> 1) & 15;
        qrow0 = 64 * c + 32 * qh; nq = 32; qpos0 = qrow0; Kb = P.QKV + 1024 + 64 * hd; kpitch = QKVW; Vb = P.VT + (size_t)(64 * hd) * MP; vpitch = MP;
        kt0 = c >= 8 ? 64 * (c - 8) : 0; kt1 = 64 * c + 64; nkeys = kt1;
    } else { const int u2 = unit - 4096, b = u2 >> 4; hd = u2 & 15;
        qrow0 = MP + 16 * b; nq = 16; qpos0 = 512; Kb = P.KS + (size_t)b * KSROWS * 1024 + 64 * hd; kpitch = 1024; Vb = P.VST + ((size_t)b * 1024 + 64 * hd) * KSROWS; vpitch = KSROWS;
        kt0 = 0; kt1 = KSROWS; nkeys = 528;
    }
    const int qv = q < nq ? q : nq - 1;
    const bf16* qp = P.QKV + (size_t)(qrow0 + qv) * QKVW + 64 * hd + 8 * h;
    bf16x8 qf[4];
#pragma unroll
    for (int s = 0; s < 4; ++s) qf[s] = *(const bf16x8*)(qp + 16 * s);
    LAS const float* tb = tbl + hd * 257;
    const int qpos = qpos0 + q;
    float m = -1e30f, l = 0.f; f32x16 o[2] = {};
    const int kr = swap23(q);
    for (int kb = kt0; kb < kt1; kb += 32) {
        const bf16* kp = Kb + (size_t)(kb + kr) * kpitch + 8 * h;
        bf16x8 kf[4], vf[2][2];
#pragma unroll
        for (int s = 0; s < 4; ++s) kf[s] = *(const bf16x8*)(kp + 16 * s);
#pragma unroll
        for (int dt = 0; dt < 2; ++dt)
#pragma unroll
            for (int s = 0; s < 2; ++s) vf[dt][s] = *(const bf16x8*)(Vb + (size_t)(32 * dt + q) * vpitch + kb + 16 * s + 8 * h);
        f32x16 st = {};
#pragma unroll
        for (int s = 0; s < 4; ++s) st = mfma32(kf[s], qf[s], st);
        float sc[16]; float mx = -1e30f;
#pragma unroll
        for (int r = 0; r < 16; ++r) {
            const int kpos = kb + 16 * (r >> 3) + 8 * h + (r & 7);
            int dist = qpos - kpos; dist = dist < -128 ? -128 : (dist > 128 ? 128 : dist);
            float s = st[r] + tb[dist + 128];
            if (kpos >= nkeys) s = -1e30f;
            sc[r] = s; mx = fmaxf(mx, s);
        }
        mx = fmaxf(mx, __shfl_xor(mx, 32));
        const float mn = fmaxf(m, mx), alpha = fexp2(m - mn); m = mn;
        float ps = 0.f;
#pragma unroll
        for (int r = 0; r < 16; ++r) { sc[r] = fexp2(sc[r] - mn); ps += sc[r]; }
        l = l * alpha + ps;
#pragma unroll
        for (int dt = 0; dt < 2; ++dt)
#pragma unroll
            for (int r = 0; r < 16; ++r) o[dt][r] *= alpha;
        v4u pa, pb;
        pa.x = pk2(sc[0], sc[1]); pa.y = pk2(sc[2], sc[3]); pa.z = pk2(sc[4], sc[5]); pa.w = pk2(sc[6], sc[7]);
        pb.x = pk2(sc[8], sc[9]); pb.y = pk2(sc[10], sc[11]); pb.z = pk2(sc[12], sc[13]); pb.w = pk2(sc[14], sc[15]);
        const bf16x8 pf0 = __builtin_bit_cast(bf16x8, pa), pf1 = __builtin_bit_cast(bf16x8, pb);
#pragma unroll
        for (int dt = 0; dt < 2; ++dt) { o[dt] = mfma32(vf[dt][0], pf0, o[dt]); o[dt] = mfma32(vf[dt][1], pf1, o[dt]); }
    }
    l += __shfl_xor(l, 32);
    const float inv = frcp(l);
    if (q < nq) {
        bf16* op = P.mix + (size_t)(qrow0 + q) * DM + 64 * hd;
#pragma unroll
        for (int dt = 0; dt < 2; ++dt)
#pragma unroll
            for (int g = 0; g < 4; ++g) { v2u w; w.x = pk2(o[dt][4 * g] * inv, o[dt][4 * g + 1] * inv); w.y = pk2(o[dt][4 * g + 2] * inv, o[dt][4 * g + 3] * inv);
                *(v2u*)(op + 32 * dt + 8 * g + 4 * h) = w; }
    }
}
__global__ void __launch_bounds__(NTHREADS, 2) mega_fwd(Args args) {
    extern __shared__ __attribute__((aligned(16))) unsigned char lds_raw[];
    LAS unsigned char* lds = (LAS unsigned char*)lds_raw;
    volatile LAS unsigned* MISC = (volatile LAS unsigned*)(lds + MISC_OFF);
    const int tid = threadIdx.x, lane = tid & 63, wave = __builtin_amdgcn_readfirstlane(tid >> 6);
    const int G = gridDim.x, bx = blockIdx.x;
    const int vcu = (G % 8 == 0) ? (bx % 8) * (G / 8) + bx / 8 : bx;
    const int gw = vcu * NWAVES + wave, NGW = G * NWAVES;
    unsigned char* ws = args.ws; float* out = args.out;
    gu32* ctl = (gu32*)(ws + WS_CTL);
    const float *x_p = args.in[0], *x_s = args.in[1], *cache_k = args.in[2], *cache_v = args.in[3], *wkv_in = args.in[4], *shift_in = args.in[5],
                *ln1 = args.in[6], *w_in = args.in[7], *rel_table = args.in[8], *mu = args.in[9], *w0 = args.in[10], *w_w2 = args.in[11], *a0 = args.in[12],
                *a_w2 = args.in[13], *g_w2 = args.in[14], *k_k = args.in[15], *k_a = args.in[16], *r_k = args.in[17], *lnx_w = args.in[18], *lnx_b = args.in[19],
                *w_o = args.in[20], *ln2 = args.in[21], *w_gate = args.in[22], *w_up = args.in[23], *w_down = args.in[24], *final_norm = args.in[25];
    bf16 *W1T = (bf16*)(ws + WS_W1T), *W2T = (bf16*)(ws + WS_W2T), *LWT = (bf16*)(ws + WS_LORA), *LAT = LWT + 1024 * 64, *LGT = LAT + 1024 * 64;
    bf16 *A1 = (bf16*)(ws + WS_A1), *QKV = (bf16*)(ws + WS_QKV), *Z = (bf16*)(ws + WS_Z), *KS = (bf16*)(ws + WS_KS), *VST = (bf16*)(ws + WS_VST), *VT = (bf16*)(ws + WS_VT);
    bf16 *HB = (bf16*)(ws + WS_HB), *W3T = (bf16*)(ws + WS_W3T), *W4T = (bf16*)(ws + WS_W4T), *FF = (bf16*)(ws + WS_FF), *MIX = A1;
    bf16 *PM = (bf16*)(ws + WS_RW + RW_PM), *Y0 = (bf16*)(ws + WS_RW + RW_Y0), *GG = (bf16*)(ws + WS_RW + RW_GG), *BN = (bf16*)(ws + WS_RW + RW_BN), *S0 = (bf16*)(ws + WS_RW + RW_S0);
    float* GC = (float*)(ws + WS_RW + RW_GC);
    float* GM = (float*)((unsigned char*)out + DO_GM); bf16* QP = (bf16*)((unsigned char*)out + DO_QP);
    float* ssq2 = (float*)(ws + WS_CTL) + CW_SSQ2; float* SLAB = (float*)(ws + WS_W3T);

    for (int u = tid; u < (LDS_BYTES - LDSCTL_OFF) / 4; u += NTHREADS) ((LAS unsigned*)(lds + LDSCTL_OFF))[u] = 0u;
    __syncthreads();
    XcdBarrier bar = xcd_barrier_post((unsigned*)(ctl + CW_BAR), MISC + 8);
#ifdef PROBE_PHASE
    unsigned long long tstamp_prev = __builtin_amdgcn_s_memrealtime(), tprobe = 0ull; int n_ph = 0;
#define GRID_BAR() do { xcd_barrier(bar); { const unsigned long long tn_ = __builtin_amdgcn_s_memrealtime(); if (n_ph == PROBE_PHASE) tprobe = tn_ - tstamp_prev; tstamp_prev = tn_; ++n_ph; } } while (0)
#else
#define GRID_BAR() xcd_barrier(bar)
#endif

    {
        P0Params P{x_p, x_s, cache_k, cache_v, ln1, w_in, w_w2, a_w2, g_w2, w_o, W1T, W2T, LWT, LAT, LGT, A1, KS, VST};
        p0_prologue(P, lds, gw, NGW, wave, lane);
    }
    GRID_BAR();
    {
        pg8::Gemm g{A1, W1T, MROWS, INW, DM}; pg8::StaticOrder S; S.init(MROWS, INW, DM, G, bx);
        EpiG1 E{QKV, Z, out};
        pg8::gemm_phase<EpiG1, pg8::StaticOrder, true, true>(lds, g, S, E);
    }
    GRID_BAR();
    {
        LAS unsigned char* scr = lds + wave * 9216;
        for (int it = gw; it < 2048; it += NGW) vt_item(QKV, VT, it, scr, lane);
        for (int it = gw; it < 256; it += NGW) samp_kv_item(QKV, KS, VST, it, lane);
        BLK_SYNC();
        RwkvParams P{Z, shift_in, mu, w0, a0, k_k, k_a, r_k, LWT, LAT, LGT, PM, Y0, GG, BN, QP, GM, GC};
        for (int ch = vcu; ch < NCH; ch += G) rwkv_chunk(P, ch, lds, tid, wave, lane);
    }
    GRID_BAR();
    {
        LAS float* tbl = (LAS float*)lds;
        for (int i = tid; i < 16 * 257; i += NTHREADS) tbl[i] = rel_table[i] * LOG2E;
        LDS_SYNC();
        ScanParams SP{PM, GM, GC, S0, wkv_in, out};
        AttnParams AP{QKV, VT, KS, VST, MIX};
        constexpr int N_LONG = 64, N_ATT = 4096 + 256, N_SHORT = 1024, N_ALL = N_LONG + N_ATT + N_SHORT;
        for (;;) {
            int it = 0;
            if (lane == 0) it = (int)__hip_atomic_fetch_add(ctl + CW_QATT, 1u, RLX_AGENT);
            it = __builtin_amdgcn_readfirstlane(it);
            if (it >= N_ALL) break;
            if (it < N_LONG) scan_task(SP, it >> 2, it & 3, lane);
            else if (it < N_LONG + N_ATT) attn_unit(AP, it - N_LONG, tbl, lane);
            else { const int s = it - N_LONG - N_ATT; scan_task(SP, 16 + (s >> 2), s & 3, lane); }
        }
    }
    GRID_BAR();
    {
        S4Params P{S0, QP, Y0, GG, BN, lnx_w, lnx_b, MIX};
        for (int it = gw; it < 2 * NCH; it += NGW) stage4_task(P, it, lane);
    }
    GRID_BAR();
    {
        pg8::Gemm g{MIX, W2T, MROWS, DM, DM}; pg8::StaticOrder S; S.init(MROWS, DM, DM, G, bx);
        EpiG2 E{x_p, x_s, out, HB, ssq2};
        pg8::gemm_phase<EpiG2, pg8::StaticOrder, true, true>(lds, g, S, E);
        BLK_SYNC();
        LAS float* scr = (LAS float*)(lds + wave * 16384);
        constexpr int I_G = (DM / 64) * (DFF / 32), I_D = (DFF / 64) * (DM / 32), N_CONV = 2 * I_G + I_D;
        for (;;) {
            int base = 0;
            if (lane == 0) base = (int)__hip_atomic_fetch_add(ctl + CW_QCONV, 8u, RLX_AGENT);
            base = __builtin_amdgcn_readfirstlane(base);
            if (base >= N_CONV) break;
            for (int it = base; it < base + 8 && it < N_CONV; ++it) {
                if (it < 2 * I_G) { const bool up = it >= I_G; const int r = up ? it - I_G : it; const int nb = DFF / 32, kb = r / nb, n0 = 32 * (r % nb);
                    tr_item(up ? w_up : w_gate, DFF, W3T, DM, 64 * kb, n0, 256 * (n0 >> 7) + (n0 & 127) + (up ? 128 : 0), ln2, scr, lane); }
                else { const int r = it - 2 * I_G; const int nb = DM / 32; tr_item(w_down, DM, W4T, DFF, 64 * (r / nb), 32 * (r % nb), 32 * (r % nb), nullptr, scr, lane); }
            }
        }
    }
    GRID_BAR();
    {
        pg8::Gemm g{HB, W3T, MROWS, 2 * DFF, DM}; pg8::StaticOrder S; S.init(MROWS, 2 * DFF, DM, G, bx);
        EpiG3 E{ssq2, FF};
        pg8::gemm_phase<EpiG3, pg8::StaticOrder, true, true>(lds, g, S, E);
    }
    GRID_BAR();
    {
        pg8::Gemm g{FF, W4T, MROWS, DM, DFF}; SchedG4 S; S.init(G, bx);
        EpiG4 E{out, SLAB};
        pg8::gemm_phase<EpiG4, SchedG4, true, true>(lds, g, S, E);
    }
    GRID_BAR();
    for (int m = gw; m < MROWS; m += NGW) final_norm_row(out + (size_t)m * DM, final_norm, m < MP ? nullptr : SLAB + (size_t)(m - MP) * DM, lane);
#ifdef PROBE_PHASE
    if (PROBE_PHASE == 8) tprobe = __builtin_amdgcn_s_memrealtime() - tstamp_prev;
    if (bx == 0) { const unsigned long long t0_ = __builtin_amdgcn_s_memrealtime(); while (__builtin_amdgcn_s_memrealtime() - t0_ < (unsigned long long)PROBE_MULT * tprobe) __builtin_amdgcn_s_sleep(8); }
#endif
}

extern "C" void kernel_launch(void* const* d_in, const int* in_sizes, int n_in, void* d_out, int out_size, void* d_ws, size_t ws_size, hipStream_t stream) {
    static int grid = 0;
    if (grid == 0) {
        if (n_in != 26 || (size_t)out_size != OUT_TOTAL || ws_size < WS_END) { fprintf(stderr, "kernel_launch: unexpected shapes (n_in %d, out %d, ws %zu < %zu)\n", n_in, out_size, ws_size, (size_t)WS_END); grid = -1; return; }
        int dev = 0, cus = 0;
        if (hipGetDevice(&dev) != hipSuccess || hipDeviceGetAttribute(&cus, hipDeviceAttributeMultiprocessorCount, dev) != hipSuccess) { grid = -1; return; }
        if (hipFuncSetAttribute((const void*)mega_fwd, hipFuncAttributeMaxDynamicSharedMemorySize, LDS_BYTES) != hipSuccess) { fprintf(stderr, "kernel_launch: hipFuncSetAttribute failed\n"); grid = -1; return; }
        (void)hipGetLastError();
        grid = cus;
    }
    if (grid < 0) return;
    if (hipMemsetAsync((char*)d_ws + WS_CTL, 0, CTL_BYTES, stream) != hipSuccess) return;
    Args a{};
    for (int i = 0; i < 26; ++i) a.in[i] = (const float*)d_in[i];
    a.out = (float*)d_out; a.ws = (unsigned char*)d_ws;
    hipLaunchKernelGGL(mega_fwd, dim3(grid), dim3(NTHREADS), LDS_BYTES, stream, a);
}
```
